# Optimizing an MI355X kernel written in HIP

```python
import jax, jax.numpy as jnp
from jax import lax
import numpy as np

D_MODEL = 1024
BATCH = 1
SEQ = 16384
DEPTH = 2
DEC_BATCH = 128
DEC_SEQ = 8
PAST_LEN = 16384
PAGE_SIZE = 128

N_A_LAYERS = DEPTH // 2
N_B_LAYERS = DEPTH - N_A_LAYERS
HEAD_DIM = 64
POOL_W = (3 * D_MODEL) // 4
POOL_WINDOWS = (2, 4, 8, 16)
POOL_GROUPS = len(POOL_WINDOWS)
POOL_GW = POOL_W // POOL_GROUPS
POOL_PAD = max(POOL_WINDOWS) - 1
N_Q_HEADS = POOL_W // HEAD_DIM
N_KV_HEADS = 4
GROUP = N_Q_HEADS // N_KV_HEADS
SWA_W = N_Q_HEADS * HEAD_DIM
KV_W = N_KV_HEADS * HEAD_DIM
WINDOW = 128
BLOCK = WINDOW
N_MEM = 256
MEM_HEADS = 4
MEM_W = MEM_HEADS * HEAD_DIM
ROT_DIM = HEAD_DIM // 4
ROPE_THETA = 500000.0
EPS = 1e-6

kernel_name = "yoco_pool_swa_sink_memxattn_step"


def rms_norm(x, g):
    xf = x.astype(jnp.float32)
    y = xf * lax.rsqrt(jnp.mean(xf * xf, axis=-1, keepdims=True) + EPS)
    return (y * g.astype(jnp.float32)).astype(x.dtype)


def rope_partial(x, pos):
    half = ROT_DIM // 2
    inv = ROPE_THETA ** (-jnp.arange(half, dtype=jnp.float32) * 2.0 / ROT_DIM)
    ang = pos.astype(jnp.float32)[:, None] * inv[None, :]
    cos = jnp.cos(ang)[:, None, :]
    sin = jnp.sin(ang)[:, None, :]
    xf = x.astype(jnp.float32)
    x1, x2, rest = xf[..., :half], xf[..., half:ROT_DIM], xf[..., ROT_DIM:]
    out = jnp.concatenate([x1 * cos - x2 * sin, x2 * cos + x1 * sin, rest], axis=-1)
    return out.astype(x.dtype)


def pool_mixer(u_ext, pos, mix_w, scale):
    T = u_ext.shape[1] - POOL_PAD
    uf = u_ext.astype(jnp.float32)
    cs = jnp.concatenate([jnp.zeros_like(uf[:, :1]), jnp.cumsum(uf, axis=1)], axis=1)
    u_new = uf[:, POOL_PAD:]
    outs = []
    for g, w in enumerate(POOL_WINDOWS):
        sl = slice(g * POOL_GW, (g + 1) * POOL_GW)
        win = cs[:, POOL_PAD + 1:POOL_PAD + 1 + T, sl] - cs[:, POOL_PAD + 1 - w:POOL_PAD + 1 - w + T, sl]
        cnt = jnp.minimum(pos + 1, w).astype(jnp.float32)[None, :, None]
        d = win / cnt - u_new[:, :, sl]
        outs.append(jnp.einsum('btc,cd->btd', d, mix_w[g].astype(jnp.float32)))
    y = jnp.concatenate(outs, axis=-1) * scale.astype(jnp.float32)
    return y.astype(u_ext.dtype)


def memory_kv(mem, g, w, k_gain):
    B, M, _ = mem.shape
    k, v = jnp.split(rms_norm(mem, g) @ w, [MEM_W], axis=-1)
    k = rms_norm(k.reshape(B, M, MEM_HEADS, HEAD_DIM), k_gain)
    return k, v.reshape(B, M, MEM_HEADS, HEAD_DIM)


def memory_branch(qm, gm, q_gain, mk, mv):
    B, T, _ = qm.shape
    q = rms_norm(qm.reshape(B, T, MEM_HEADS, HEAD_DIM), q_gain)
    s = jnp.einsum('bthd,bmhd->bhtm', q.astype(jnp.float32), mk.astype(jnp.float32)) * HEAD_DIM ** -0.5
    p = jax.nn.softmax(s, axis=-1)
    o = jnp.einsum('bhtm,bmhd->bthd', p, mv.astype(jnp.float32)).astype(qm.dtype)
    return o.reshape(B, T, MEM_W) * jax.nn.silu(gm)


def sink_softmax(s, mask, sinks):
    s = jnp.where(mask, s, -jnp.inf)
    sk = sinks.astype(jnp.float32).reshape(N_KV_HEADS, GROUP, 1, 1)
    m = jnp.maximum(jnp.max(s, axis=-1, keepdims=True), sk)
    p = jnp.exp(s - m)
    return p / (jnp.sum(p, axis=-1, keepdims=True) + jnp.exp(sk - m))


def swa_banded(q, k, v, sinks):
    B, S = q.shape[:2]
    nb = S // BLOCK
    qb = q.reshape(B, nb, BLOCK, N_KV_HEADS, GROUP, HEAD_DIM).astype(jnp.float32)

    def band(t):
        tb = t.reshape(B, nb, BLOCK, N_KV_HEADS, HEAD_DIM).astype(jnp.float32)
        prev = jnp.concatenate([jnp.zeros_like(tb[:, :1]), tb[:, :-1]], axis=1)
        return jnp.concatenate([prev, tb], axis=2)

    kk, vv = band(k), band(v)
    s = jnp.einsum('bnqhgd,bnkhd->bnhgqk', qb, kk) * HEAD_DIM ** -0.5
    qpos = jnp.arange(BLOCK)
    kpos = jnp.arange(2 * BLOCK) - BLOCK
    diff = qpos[:, None] - kpos[None, :]
    blk = jnp.arange(nb)[:, None, None] * BLOCK
    mask = (diff >= 0) & (diff < WINDOW) & (blk + kpos[None, None, :] >= 0)
    p = sink_softmax(s, mask[None, :, None, None], sinks)
    o = jnp.einsum('bnhgqk,bnkhd->bnqhgd', p, vv)
    return o.reshape(B, S, SWA_W).astype(q.dtype)


def swa_window(q, k_all, v_all, q_pos, k_pos, sinks):
    B, T = q.shape[:2]
    qg = q.reshape(B, T, N_KV_HEADS, GROUP, HEAD_DIM).astype(jnp.float32)
    s = jnp.einsum('bqhgd,bkhd->bhgqk', qg, k_all.astype(jnp.float32)) * HEAD_DIM ** -0.5
    diff = q_pos[:, None] - k_pos[None, :]
    mask = (diff >= 0) & (diff < WINDOW)
    p = sink_softmax(s, mask, sinks)
    o = jnp.einsum('bhgqk,bkhd->bqhgd', p, v_all.astype(jnp.float32))
    return o.reshape(B, T, SWA_W).astype(q.dtype)


def forward(x, pos, pool_prefix, swa_past_k, swa_past_v, mem_k, mem_v,
            norm_a, w_in_a, pool_mix_w, pool_scale, w_out_a, kv_norm, w_kv, k_norm,
            norm_b, w_in_b, q_norm, sinks, w_out_b, mem_q_norm):
    B, T, _ = x.shape
    new_pool = []
    for i in range(N_A_LAYERS):
        z = rms_norm(x, norm_a[i]) @ w_in_a[i]
        u, gp, qm, gm = jnp.split(z, [POOL_W, 2 * POOL_W, 2 * POOL_W + MEM_W], axis=-1)
        u_ext = jnp.concatenate([pool_prefix[i].astype(u.dtype), u], axis=1)
        yp = pool_mixer(u_ext, pos, pool_mix_w[i], pool_scale[i]) * jax.nn.silu(gp)
        ym = memory_branch(qm, gm, mem_q_norm[i], mem_k[i], mem_v[i])
        x = x + jnp.concatenate([yp, ym], axis=-1) @ w_out_a[i]
        new_pool.append(u_ext[:, -POOL_PAD:])
    k, v = jnp.split(rms_norm(x, kv_norm) @ w_kv, [KV_W], axis=-1)
    k = rope_partial(rms_norm(k.reshape(B, T, N_KV_HEADS, HEAD_DIM), k_norm), pos)
    v = v.reshape(B, T, N_KV_HEADS, HEAD_DIM)
    if swa_past_k is None:
        keep = min(WINDOW, T)
        new_k, new_v = k[:, -keep:], v[:, -keep:]
    else:
        L = swa_past_k.shape[1]
        k_all = jnp.concatenate([swa_past_k.astype(k.dtype), k], axis=1)
        v_all = jnp.concatenate([swa_past_v.astype(v.dtype), v], axis=1)
        k_pos = pos[0] - L + jnp.arange(L + T)
        new_k, new_v = k_all[:, -L:], v_all[:, -L:]
    for j in range(N_B_LAYERS):
        li = N_A_LAYERS + j
        z = rms_norm(x, norm_b[j]) @ w_in_b[j]
        q, gq, qm, gm = jnp.split(z, [SWA_W, 2 * SWA_W, 2 * SWA_W + MEM_W], axis=-1)
        q = rope_partial(rms_norm(q.reshape(B, T, N_Q_HEADS, HEAD_DIM), q_norm[j]), pos)
        if swa_past_k is None:
            o = swa_banded(q, k, v, sinks[j])
        else:
            o = swa_window(q, k_all, v_all, pos, k_pos, sinks[j])
        ys = o * jax.nn.silu(gq)
        ym = memory_branch(qm, gm, mem_q_norm[li], mem_k[li], mem_v[li])
        x = x + jnp.concatenate([ys, ym], axis=-1) @ w_out_b[j]
    return x, jnp.stack(new_pool), new_k, new_v


def setup_inputs(seed: int = 0) -> dict:
    key = jax.random.key(seed)
    ks = jax.random.split(key, 26)
    f32 = jnp.float32

    def nrm(k, shape, scale=1.0):
        return jax.random.normal(k, shape, f32) * scale

    def gain(k, shape):
        return 1.0 + 0.02 * jax.random.normal(k, shape, f32)

    w_buf = min(WINDOW, PAST_LEN)
    return {
        "x_prompt": nrm(ks[0], (BATCH, SEQ, D_MODEL)),
        "x_sample": nrm(ks[1], (DEC_BATCH, DEC_SEQ, D_MODEL)),
        "state_pool": nrm(ks[2], (N_A_LAYERS, DEC_BATCH, POOL_PAD, POOL_W)),
        "cache_swa_k": nrm(ks[3], (DEC_BATCH, w_buf, N_KV_HEADS, HEAD_DIM)),
        "cache_swa_v": nrm(ks[4], (DEC_BATCH, w_buf, N_KV_HEADS, HEAD_DIM)),
        "cache_mem_k": nrm(ks[5], (DEPTH, DEC_BATCH, N_MEM, MEM_HEADS, HEAD_DIM)),
        "cache_mem_v": nrm(ks[6], (DEPTH, DEC_BATCH, N_MEM, MEM_HEADS, HEAD_DIM)),
        "mem_prompt": nrm(ks[7], (BATCH, N_MEM, D_MODEL)),
        "norm_a": gain(ks[8], (N_A_LAYERS, D_MODEL)),
        "w_in_a": nrm(ks[9], (N_A_LAYERS, D_MODEL, 2 * POOL_W + 2 * MEM_W), D_MODEL ** -0.5),
        "pool_mix_w": nrm(ks[10], (N_A_LAYERS, POOL_GROUPS, POOL_GW, POOL_GW), POOL_GW ** -0.5),
        "pool_scale": 1.0 + 0.1 * jax.random.normal(ks[11], (N_A_LAYERS, POOL_W), f32),
        "w_out_a": nrm(ks[12], (N_A_LAYERS, POOL_W + MEM_W, D_MODEL), (POOL_W + MEM_W) ** -0.5),
        "kv_norm": gain(ks[13], (D_MODEL,)),
        "w_kv": nrm(ks[14], (D_MODEL, 2 * KV_W), D_MODEL ** -0.5),
        "k_norm": gain(ks[15], (HEAD_DIM,)),
        "norm_b": gain(ks[16], (N_B_LAYERS, D_MODEL)),
        "w_in_b": nrm(ks[17], (N_B_LAYERS, D_MODEL, 2 * SWA_W + 2 * MEM_W), D_MODEL ** -0.5),
        "q_norm": gain(ks[18], (N_B_LAYERS, HEAD_DIM)),
        "sinks": nrm(ks[19], (N_B_LAYERS, N_Q_HEADS), 1.0),
        "w_out_b": nrm(ks[20], (N_B_LAYERS, SWA_W + MEM_W, D_MODEL), (SWA_W + MEM_W) ** -0.5),
        "mem_norm": gain(ks[21], (DEPTH, D_MODEL)),
        "w_mem_kv": nrm(ks[22], (DEPTH, D_MODEL, 2 * MEM_W), D_MODEL ** -0.5),
        "mem_q_norm": gain(ks[23], (DEPTH, HEAD_DIM)),
        "mem_k_norm": gain(ks[24], (DEPTH, HEAD_DIM)),
    }


def reference(x_prompt, x_sample, state_pool, cache_swa_k, cache_swa_v, cache_mem_k, cache_mem_v, mem_prompt,
              norm_a, w_in_a, pool_mix_w, pool_scale, w_out_a, kv_norm, w_kv, k_norm,
              norm_b, w_in_b, q_norm, sinks, w_out_b, mem_norm, w_mem_kv, mem_q_norm, mem_k_norm):
    mk_list, mv_list = [], []
    for l in range(DEPTH):
        mk, mv = memory_kv(mem_prompt, mem_norm[l], w_mem_kv[l], mem_k_norm[l])
        mk_list.append(mk)
        mv_list.append(mv)
    mem_k_prompt = jnp.stack(mk_list)
    mem_v_prompt = jnp.stack(mv_list)

    weights = (norm_a, w_in_a, pool_mix_w, pool_scale, w_out_a, kv_norm, w_kv, k_norm,
               norm_b, w_in_b, q_norm, sinks, w_out_b, mem_q_norm)

    bp, s_len, _ = x_prompt.shape
    pool_zero = jnp.zeros((N_A_LAYERS, bp, POOL_PAD, POOL_W), x_prompt.dtype)
    y_prompt, pool_p, swa_k_p, swa_v_p = forward(
        x_prompt, jnp.arange(s_len), pool_zero, None, None, mem_k_prompt, mem_v_prompt, *weights)

    pos_s = PAST_LEN + jnp.arange(x_sample.shape[1])
    y_sample, pool_s, swa_k_s, swa_v_s = forward(
        x_sample, pos_s, state_pool, cache_swa_k, cache_swa_v, cache_mem_k, cache_mem_v, *weights)

    return (y_prompt, y_sample, pool_p, pool_s, swa_k_p, swa_v_p, swa_k_s, swa_v_s, mem_k_prompt, mem_v_prompt)
```

```cpp
#include <hip/hip_runtime.h>
#include <hip/hip_cooperative_groups.h>
#include <cstdio>
#include <cmath>
namespace cg = cooperative_groups;

#ifndef MULTI_LAUNCH
#define MULTI_LAUNCH 1
#endif

typedef unsigned short bf16;
typedef short bf16x8 __attribute__((ext_vector_type(8)));
typedef short s16x4 __attribute__((ext_vector_type(4)));
typedef float f32x16 __attribute__((ext_vector_type(16)));
typedef float f32x4 __attribute__((ext_vector_type(4)));
typedef unsigned u32x4 __attribute__((ext_vector_type(4)));
typedef unsigned u32x2 __attribute__((ext_vector_type(2)));
#define DI __device__ __forceinline__
#define MFMA32(a, b, c) __builtin_amdgcn_mfma_f32_32x32x16_bf16((a), (b), (c), 0, 0, 0)

constexpr int NTOK = 17408, NPR = 16384, DM = 1024;
constexpr float EPS = 1e-6f;
constexpr float LOG2E = 1.4426950408889634f;
constexpr size_t O_Y = 0, O_POOLP = 17825792, O_POOLS = 17837312, O_SKP = 19311872, O_SVP = 19344640,
                 O_SKS = 19377408, O_SVS = 23571712, O_MKP = 27766016, O_MVP = 27897088;

struct Params {
  const float *xp, *xs, *state_pool, *cswk, *cswv, *cmk, *cmv, *memp;
  const float *norm_a, *w_in_a, *pool_mix_w, *pool_scale, *w_out_a, *kv_norm, *w_kv, *k_norm, *norm_b, *w_in_b, *q_norm,
      *sinks, *w_out_b, *mem_norm, *w_mem_kv, *mem_q_norm, *mem_k_norm;
  float* out;
  bf16 *Wt_in_a, *Wt_out_a, *Wt_kvb, *Wt_out_b, *Wt_mem, *Wt_pool;
  bf16 *xb, *act, *z, *memb, *mkb;
  float *rstd_a, *rstd_mem, *ssq1;
  float rope_inv[8];
};

DI unsigned pack2(float a, float b) {
  typedef __bf16 bf2 __attribute__((ext_vector_type(2)));
  typedef float f2 __attribute__((ext_vector_type(2)));
  f2 f = {a, b};
  return __builtin_bit_cast(unsigned, __builtin_convertvector(f, bf2));
}
DI float bflo(unsigned u) { return __uint_as_float(u << 16); }
DI float bfhi(unsigned u) { return __uint_as_float(u & 0xffff0000u); }
DI float silu(float x) { return x / (1.f + __expf(-x)); }
DI int crow(int i, int h) { return (i & 3) + 8 * (i >> 2) + 4 * h; }
DI const float* xrow(const Params& p, int tok) { return tok < NPR ? p.xp + (size_t)tok * DM : p.xs + (size_t)(tok - NPR) * DM; }

template <int BN, class Epi>
DI void gemm_tile(const bf16* __restrict__ A, int lda, const bf16* __restrict__ Bt, int ldb, int K, int m0, int n0, char* smem, const Epi& epi) {
  constexpr int WN = BN / 64, WM = 4 / WN, MI = 128 / WM / 32;
  constexpr int A_BYTES = 128 * 128, B_BYTES = BN * 128, STAGE = A_BYTES + B_BYTES, NB = BN / 32;
  const int tid = threadIdx.x, lane = tid & 63, w = tid >> 6;
  const int wm = w / WN, wn = w % WN, r = lane & 31, h = lane >> 5;
  f32x16 acc[MI][2];
#pragma unroll
  for (int mi = 0; mi < MI; ++mi)
#pragma unroll
    for (int ni = 0; ni < 2; ++ni)
#pragma unroll
      for (int i = 0; i < 16; ++i) acc[mi][ni][i] = 0.f;
  const int lrow = tid >> 3, lkc = tid & 7;
  const bf16* Ag = A + (size_t)(m0 + lrow) * lda + lkc * 8;
  const bf16* Bg = Bt + (size_t)(n0 + lrow) * ldb + lkc * 8;
  const int lds_w = lrow * 128 + ((lkc ^ ((lrow >> 1) & 7)) << 4);
  u32x4 ra[4], rb[NB];
#pragma unroll
  for (int i = 0; i < 4; ++i) ra[i] = *(const u32x4*)(Ag + (size_t)(32 * i) * lda);
#pragma unroll
  for (int i = 0; i < NB; ++i) rb[i] = *(const u32x4*)(Bg + (size_t)(32 * i) * ldb);
#pragma unroll
  for (int i = 0; i < 4; ++i) *(u32x4*)(smem + lds_w + i * 4096) = ra[i];
#pragma unroll
  for (int i = 0; i < NB; ++i) *(u32x4*)(smem + A_BYTES + lds_w + i * 4096) = rb[i];
  __syncthreads();
  const int nk = K / 64;
#pragma unroll 1
  for (int kt = 0; kt < nk; ++kt) {
    if (kt + 1 < nk) {
#pragma unroll
      for (int i = 0; i < 4; ++i) ra[i] = *(const u32x4*)(Ag + (size_t)(32 * i) * lda + (kt + 1) * 64);
#pragma unroll
      for (int i = 0; i < NB; ++i) rb[i] = *(const u32x4*)(Bg + (size_t)(32 * i) * ldb + (kt + 1) * 64);
    }
    const char* sa = smem + (kt & 1) * STAGE;
    const char* sb = sa + A_BYTES;
#pragma unroll
    for (int ks = 0; ks < 4; ++ks) {
      bf16x8 af[MI], bfr[2];
      const int chunk = ks * 2 + h;
#pragma unroll
      for (int mi = 0; mi < MI; ++mi) {
        const int row = wm * (MI * 32) + mi * 32 + r;
        af[mi] = *(const bf16x8*)(sa + row * 128 + ((chunk ^ ((row >> 1) & 7)) << 4));
      }
#pragma unroll
      for (int ni = 0; ni < 2; ++ni) {
        const int row = wn * 64 + ni * 32 + r;
        bfr[ni] = *(const bf16x8*)(sb + row * 128 + ((chunk ^ ((row >> 1) & 7)) << 4));
      }
#pragma unroll
      for (int mi = 0; mi < MI; ++mi)
#pragma unroll
        for (int ni = 0; ni < 2; ++ni) acc[mi][ni] = MFMA32(af[mi], bfr[ni], acc[mi][ni]);
    }
    if (kt + 1 < nk) {
      char* d = smem + ((kt + 1) & 1) * STAGE;
#pragma unroll
      for (int i = 0; i < 4; ++i) *(u32x4*)(d + lds_w + i * 4096) = ra[i];
#pragma unroll
      for (int i = 0; i < NB; ++i) *(u32x4*)(d + A_BYTES + lds_w + i * 4096) = rb[i];
    }
    __syncthreads();
  }
  constexpr int CP = BN + 4, NC = BN / 4;
  float* Cs = (float*)smem;
  const int whalf = (wm * MI * 32) >> 6;
#pragma unroll 1
  for (int half = 0; half < 2; ++half) {
    if (half) __syncthreads();
    if (whalf == half) {
#pragma unroll
      for (int mi = 0; mi < MI; ++mi)
#pragma unroll
        for (int ni = 0; ni < 2; ++ni)
#pragma unroll
          for (int i = 0; i < 16; ++i) {
            const int lr = wm * (MI * 32) + mi * 32 + crow(i, h) - 64 * half;
            Cs[lr * CP + wn * 64 + ni * 32 + r] = acc[mi][ni][i];
          }
    }
    __syncthreads();
    const int prow = tid >> 2, pq = tid & 3;
    float v[NC];
#pragma unroll
    for (int j = 0; j < NC / 4; ++j) {
      f32x4 t = *(const f32x4*)(Cs + prow * CP + pq * NC + 4 * j);
      v[4 * j] = t[0]; v[4 * j + 1] = t[1]; v[4 * j + 2] = t[2]; v[4 * j + 3] = t[3];
    }
    epi(m0 + 64 * half + prow, n0 + pq * NC, v);
  }
  __syncthreads();
}

template <int NC>
DI void store_bf16(bf16* dst, const float (&v)[NC]) {
#pragma unroll
  for (int j = 0; j < NC / 8; ++j) {
    u32x4 o = {pack2(v[8 * j], v[8 * j + 1]), pack2(v[8 * j + 2], v[8 * j + 3]), pack2(v[8 * j + 4], v[8 * j + 5]), pack2(v[8 * j + 6], v[8 * j + 7])};
    *(u32x4*)(dst + 8 * j) = o;
  }
}
template <int NC>
DI void store_f32(float* dst, const float (&v)[NC]) {
#pragma unroll
  for (int j = 0; j < NC / 4; ++j) { f32x4 o = {v[4 * j], v[4 * j + 1], v[4 * j + 2], v[4 * j + 3]}; *(f32x4*)(dst + 4 * j) = o; }
}
DI void head_rmsnorm(float (&v)[32], const float* gain, int hoff, float post) {
  float ss = 0.f;
#pragma unroll
  for (int j = 0; j < 32; ++j) ss += v[j] * v[j];
  ss += __shfl_xor(ss, 1);
  const float rs = rsqrtf(ss * (1.f / 64.f) + EPS) * post;
#pragma unroll
  for (int j = 0; j < 32; ++j) v[j] = v[j] * rs * gain[hoff + j];
}
DI void rope16(float (&v)[32], int pos, const float* inv) {
#pragma unroll
  for (int i = 0; i < 8; ++i) {
    double rev = (double)pos * (double)inv[i] * 0.15915494309189535;
    rev -= floor(rev);
    const float fr = (float)rev;
    const float sn = __builtin_amdgcn_sinf(fr), cs = __builtin_amdgcn_cosf(fr);
    const float a = v[i], b = v[i + 8];
    v[i] = a * cs - b * sn;
    v[i + 8] = b * cs + a * sn;
  }
}

struct EpiInA {
  const Params& p;
  DI void operator()(int row, int col, float (&v)[32]) const {
    const float rs = p.rstd_a[row];
#pragma unroll
    for (int j = 0; j < 32; ++j) v[j] *= rs;
    if (col < 768) {
      if (row >= NPR - 15) {
        if (row < NPR) store_f32<32>(p.out + O_POOLP + (size_t)(row - (NPR - 15)) * 768 + col, v);
        else { const int s = row - NPR, b = s >> 3, t = s & 7; store_f32<32>(p.out + O_POOLS + (size_t)(b * 15 + 7 + t) * 768 + col, v); }
      }
    } else if (col < 1536) {
#pragma unroll
      for (int j = 0; j < 32; ++j) v[j] = silu(v[j]);
    } else if (col < 1792) {
      head_rmsnorm(v, p.mem_q_norm, col & 63, 0.125f);
    } else {
#pragma unroll
      for (int j = 0; j < 32; ++j) v[j] = silu(v[j]);
    }
    store_bf16<32>(p.z + (size_t)row * 2048 + col, v);
  }
};
struct EpiMemKV {
  const Params& p;
  DI void operator()(int row, int col, float (&v)[32]) const {
    const float rs = p.rstd_mem[row];
#pragma unroll
    for (int j = 0; j < 32; ++j) v[j] *= rs;
    const int l = col >> 9, wi = col & 511;
    const bool isk = wi < 256;
    if (isk) head_rmsnorm(v, p.mem_k_norm + l * 64, col & 63, 1.f);
    const size_t e = (size_t)(l * 256 + row) * 256 + (wi & 255) + (isk ? 0 : 131072);
    store_f32<32>(p.out + O_MKP + e, v);
    store_bf16<32>(p.mkb + e, v);
  }
};
struct EpiPool {
  const Params& p; int g;
  DI void operator()(int row, int col, float (&v)[16]) const {
    const int c = g * 192 + col;
    const bf16* gp = p.z + (size_t)row * 2048 + 768 + c;
    const u32x4 g0 = *(const u32x4*)gp, g1 = *(const u32x4*)(gp + 8);
    const float* sc = p.pool_scale + c;
#pragma unroll
    for (int j = 0; j < 4; ++j) {
      v[2 * j] *= sc[2 * j] * bflo(g0[j]); v[2 * j + 1] *= sc[2 * j + 1] * bfhi(g0[j]);
      v[8 + 2 * j] *= sc[8 + 2 * j] * bflo(g1[j]); v[9 + 2 * j] *= sc[9 + 2 * j] * bfhi(g1[j]);
    }
    store_bf16<16>(p.act + (size_t)row * 1024 + c, v);
  }
};
struct EpiOutA {
  const Params& p;
  DI void operator()(int row, int col, float (&v)[32]) const {
    const float* xr = xrow(p, row) + col;
    float ss = 0.f;
#pragma unroll
    for (int j = 0; j < 8; ++j) {
      const f32x4 t = *(const f32x4*)(xr + 4 * j);
      v[4 * j] += t[0]; v[4 * j + 1] += t[1]; v[4 * j + 2] += t[2]; v[4 * j + 3] += t[3];
    }
#pragma unroll
    for (int j = 0; j < 32; ++j) ss += v[j] * v[j];
    ss += __shfl_xor(ss, 1);
    ss += __shfl_xor(ss, 2);
    if ((threadIdx.x & 3) == 0) atomicAdd(p.ssq1 + row, ss);
    store_f32<32>(p.out + O_Y + (size_t)row * 1024 + col, v);
    store_bf16<32>(p.xb + (size_t)row * 1024 + col, v);
  }
};
struct EpiKVB {
  const Params& p;
  DI void operator()(int row, int col, float (&v)[32]) const {
    const float rs = rsqrtf(p.ssq1[row] * (1.f / 1024.f) + EPS);
#pragma unroll
    for (int j = 0; j < 32; ++j) v[j] *= rs;
    const int pos = row < NPR ? row : NPR + ((row - NPR) & 7);
    if (col < 512) {
      if (col < 256) {
        head_rmsnorm(v, p.k_norm, col & 63, 1.f);
        if ((col & 63) == 0) rope16(v, pos, p.rope_inv);
      }
      const size_t ob = col < 256 ? 0 : (O_SVP - O_SKP);
      const size_t obs = col < 256 ? 0 : (O_SVS - O_SKS);
      const int c = col & 255;
      if (row >= NPR - 128) {
        if (row < NPR) store_f32<32>(p.out + O_SKP + ob + (size_t)(row - (NPR - 128)) * 256 + c, v);
        else { const int s = row - NPR, b = s >> 3, t = s & 7; store_f32<32>(p.out + O_SKS + obs + (size_t)(b * 128 + 120 + t) * 256 + c, v); }
      }
    } else if (col < 1280) {
      head_rmsnorm(v, p.q_norm, col & 63, 0.125f);
      if ((col & 63) == 0) rope16(v, pos, p.rope_inv);
    } else if (col < 2048) {
#pragma unroll
      for (int j = 0; j < 32; ++j) v[j] = silu(v[j]);
    } else if (col < 2304) {
      head_rmsnorm(v, p.mem_q_norm + 64, col & 63, 0.125f);
    } else {
#pragma unroll
      for (int j = 0; j < 32; ++j) v[j] = silu(v[j]);
    }
    store_bf16<32>(p.z + (size_t)row * 2560 + col, v);
  }
};
struct EpiOutB {
  const Params& p;
  DI void operator()(int row, int col, float (&v)[32]) const {
    float* yr = p.out + O_Y + (size_t)row * 1024 + col;
#pragma unroll
    for (int j = 0; j < 8; ++j) {
      f32x4 t = *(const f32x4*)(yr + 4 * j);
      t[0] += v[4 * j]; t[1] += v[4 * j + 1]; t[2] += v[4 * j + 2]; t[3] += v[4 * j + 3];
      *(f32x4*)(yr + 4 * j) = t;
    }
  }
};

DI void attn_chunk(const bf16x8 (&qf)[4], const char* kimg, const char* vimg, float& m, float& l, f32x16 (&o)[2], int lane, int lo, int hi) {
  const int r = lane & 31, h = lane >> 5;
  f32x16 s[2];
#pragma unroll
  for (int kt = 0; kt < 2; ++kt) {
#pragma unroll
    for (int i = 0; i < 16; ++i) s[kt][i] = 0.f;
#pragma unroll
    for (int ks = 0; ks < 4; ++ks) {
      const int row = kt * 32 + r, chunk = ks * 2 + h;
      const bf16x8 kf = *(const bf16x8*)(kimg + row * 128 + ((chunk ^ ((row >> 1) & 7)) << 4));
      s[kt] = MFMA32(kf, qf[ks], s[kt]);
    }
  }
  float mx = -1e30f;
#pragma unroll
  for (int kt = 0; kt < 2; ++kt)
#pragma unroll
    for (int i = 0; i < 16; ++i) {
      const int kk = kt * 32 + crow(i, h);
      const bool ok = (kk >= lo) && (kk <= hi);
      s[kt][i] = ok ? s[kt][i] : -1e30f;
      mx = fmaxf(mx, s[kt][i]);
    }
  mx = fmaxf(mx, __shfl_xor(mx, 32));
  const float mn = fmaxf(m, mx);
  const float alpha = __builtin_amdgcn_exp2f((m - mn) * LOG2E);
  m = mn;
  float ps = 0.f;
#pragma unroll
  for (int kt = 0; kt < 2; ++kt)
#pragma unroll
    for (int i = 0; i < 16; ++i) {
      const float pv = s[kt][i] > -1e29f ? __builtin_amdgcn_exp2f((s[kt][i] - mn) * LOG2E) : 0.f;
      s[kt][i] = pv;
      ps += pv;
    }
  l = l * alpha + ps;
#pragma unroll
  for (int dt = 0; dt < 2; ++dt)
#pragma unroll
    for (int i = 0; i < 16; ++i) o[dt][i] *= alpha;
  const int i16 = lane & 15, q = i16 >> 2, pp = i16 & 3, blk = (lane >> 4) & 1;
#pragma unroll
  for (int kt = 0; kt < 2; ++kt)
#pragma unroll
    for (int st = 0; st < 2; ++st) {
      u32x4 pk = {pack2(s[kt][8 * st], s[kt][8 * st + 1]), pack2(s[kt][8 * st + 2], s[kt][8 * st + 3]),
                  pack2(s[kt][8 * st + 4], s[kt][8 * st + 5]), pack2(s[kt][8 * st + 6], s[kt][8 * st + 7])};
      const bf16x8 pf = __builtin_bit_cast(bf16x8, pk);
      const int row = kt * 32 + st * 16 + 4 * h + q;
#pragma unroll
      for (int dt = 0; dt < 2; ++dt) {
        const int cb = (dt * 32 + blk * 16 + pp * 4) * 2;
        const int a0 = row * 128 + (cb ^ (((row >> 1) & 1) << 6));
        const s16x4 lo4 = __builtin_amdgcn_ds_read_tr16_b64_v4i16((s16x4 __attribute__((address_space(3)))*)(vimg + a0));
        const s16x4 hi4 = __builtin_amdgcn_ds_read_tr16_b64_v4i16((s16x4 __attribute__((address_space(3)))*)(vimg + a0 + 8 * 128));
        const bf16x8 vf = __builtin_shufflevector(lo4, hi4, 0, 1, 2, 3, 4, 5, 6, 7);
        o[dt] = MFMA32(vf, pf, o[dt]);
      }
    }
}
DI void attn_store(const f32x16 (&o)[2], float l, int lane, bool valid, bf16* dst, const bf16* gate) {
  const int h = lane >> 5;
  const float lt = l + __shfl_xor(l, 32);
  const float inv = 1.f / lt;
  if (valid) {
#pragma unroll
    for (int dt = 0; dt < 2; ++dt)
#pragma unroll
      for (int g4 = 0; g4 < 4; ++g4) {
        const int d0 = dt * 32 + g4 * 8 + 4 * h;
        const u32x2 gg = *(const u32x2*)(gate + d0);
        u32x2 ov = {pack2(o[dt][4 * g4] * inv * bflo(gg[0]), o[dt][4 * g4 + 1] * inv * bfhi(gg[0])),
                    pack2(o[dt][4 * g4 + 2] * inv * bflo(gg[1]), o[dt][4 * g4 + 3] * inv * bfhi(gg[1]))};
        *(u32x2*)(dst + d0) = ov;
      }
  }
}
DI void load_q(bf16x8 (&qf)[4], const bf16* qrow, int h) {
#pragma unroll
  for (int ks = 0; ks < 4; ++ks) qf[ks] = *(const bf16x8*)(qrow + ks * 16 + 8 * h);
}
DI void stage_bf16_256(char* img, const bf16* src, int ld, bool vimg, int zero_below) {
  const int tid = threadIdx.x;
#pragma unroll
  for (int i = 0; i < 8; ++i) {
    const int id = tid + 256 * i, row = id >> 3, kc = id & 7;
    u32x4 t = {0u, 0u, 0u, 0u};
    if (row >= zero_below) t = *(const u32x4*)(src + (ptrdiff_t)row * ld + kc * 8);
    const int sw = vimg ? (kc ^ (((row >> 1) & 1) << 2)) : (kc ^ ((row >> 1) & 7));
    *(u32x4*)(img + row * 128 + (sw << 4)) = t;
  }
}

DI void mem_attn_prompt(const Params& p, int layer, int unit, char* smem) {
  const int tt = unit >> 2, hh = unit & 3;
  const int lane = threadIdx.x & 63, w = threadIdx.x >> 6, r = lane & 31, h = lane >> 5;
  const int ldz = layer ? 2560 : 2048, qcol = layer ? 2048 : 1536, gcol = layer ? 2304 : 1792;
  char* kimg = smem; char* vimg = smem + 32768;
  stage_bf16_256(kimg, p.mkb + (size_t)layer * 65536 + hh * 64, 256, false, 0);
  stage_bf16_256(vimg, p.mkb + 131072 + (size_t)layer * 65536 + hh * 64, 256, true, 0);
  const int tok = tt * 128 + w * 32 + r;
  bf16x8 qf[4];
  load_q(qf, p.z + (size_t)tok * ldz + qcol + hh * 64, h);
  __syncthreads();
  float m = -1e30f, l = 0.f;
  f32x16 o[2];
#pragma unroll
  for (int dt = 0; dt < 2; ++dt)
#pragma unroll
    for (int i = 0; i < 16; ++i) o[dt][i] = 0.f;
#pragma unroll 1
  for (int c = 0; c < 4; ++c) attn_chunk(qf, kimg + c * 8192, vimg + c * 8192, m, l, o, lane, 0, 63);
  attn_store(o, l, lane, true, p.act + (size_t)tok * 1024 + 768 + hh * 64, p.z + (size_t)tok * ldz + gcol + hh * 64);
  __syncthreads();
}
DI void swa_prompt(const Params& p, int unit, char* smem) {
  const int n = unit >> 2, kvh = unit & 3;
  const int lane = threadIdx.x & 63, w = threadIdx.x >> 6, r = lane & 31, h = lane >> 5;
  char* kimg = smem; char* vimg = smem + 32768;
  const bf16* kv0 = p.z + (ptrdiff_t)(n * 128 - 128) * 2560 + kvh * 64;
  const int zb = n == 0 ? 128 : 0;
  stage_bf16_256(kimg, kv0, 2560, false, zb);
  stage_bf16_256(vimg, kv0 + 256, 2560, true, zb);
  __syncthreads();
  const int t = w * 32 + r, tok = n * 128 + t;
  const int klo = (n == 0 && t + 1 < 128) ? 128 : t + 1, khi = t + 128;
  const int c0 = (32 * w + 1) >> 6, c1 = (32 * w + 159) >> 6;
#pragma unroll 1
  for (int g = 0; g < 3; ++g) {
    const int head = kvh * 3 + g;
    bf16x8 qf[4];
    load_q(qf, p.z + (size_t)tok * 2560 + 512 + head * 64, h);
    float m = p.sinks[head], l = h == 0 ? 1.f : 0.f;
    f32x16 o[2];
#pragma unroll
    for (int dt = 0; dt < 2; ++dt)
#pragma unroll
      for (int i = 0; i < 16; ++i) o[dt][i] = 0.f;
#pragma unroll 1
    for (int c = c0; c <= c1; ++c) attn_chunk(qf, kimg + c * 8192, vimg + c * 8192, m, l, o, lane, klo - 64 * c, khi - 64 * c);
    attn_store(o, l, lane, true, p.act + (size_t)tok * 1024 + head * 64, p.z + (size_t)tok * 2560 + 1280 + head * 64);
  }
  __syncthreads();
}
DI void stage_f32_chunk(char* img, const float* src, int key0, int nvalid_f32, const bf16* extra, int ld, int nextra, bool vimg) {
  const int tid = threadIdx.x;
#pragma unroll 2
  for (int i = 0; i < 8; ++i) {
    const int id = tid + 256 * i, key = id >> 5, rem = id & 31, hh = rem >> 3, kc = rem & 7;
    const int kk = key0 + key;
    u32x4 t = {0u, 0u, 0u, 0u};
    if (kk < nvalid_f32) {
      const float* s = src + (size_t)kk * 256 + hh * 64 + kc * 8;
      const f32x4 a = *(const f32x4*)s, b = *(const f32x4*)(s + 4);
      t[0] = pack2(a[0], a[1]); t[1] = pack2(a[2], a[3]); t[2] = pack2(b[0], b[1]); t[3] = pack2(b[2], b[3]);
    } else if (kk - nvalid_f32 < nextra) {
      t = *(const u32x4*)(extra + (size_t)(kk - nvalid_f32) * ld + hh * 64 + kc * 8);
    }
    const int sw = vimg ? (kc ^ (((key >> 1) & 1) << 2)) : (kc ^ ((key >> 1) & 7));
    *(u32x4*)(img + hh * 8192 + key * 128 + (sw << 4)) = t;
  }
}
DI void mem_attn_sample(const Params& p, int layer, int b, char* smem) {
  const int lane = threadIdx.x & 63, w = threadIdx.x >> 6, r = lane & 31, h = lane >> 5;
  const int ldz = layer ? 2560 : 2048, qcol = layer ? 2048 : 1536, gcol = layer ? 2304 : 1792;
  char* kimg = smem; char* vimg = smem + 32768;
  const int tok = NPR + b * 8 + (r & 7);
  bf16x8 qf[4];
  load_q(qf, p.z + (size_t)tok * ldz + qcol + w * 64, h);
  float m = -1e30f, l = 0.f;
  f32x16 o[2];
#pragma unroll
  for (int dt = 0; dt < 2; ++dt)
#pragma unroll
    for (int i = 0; i < 16; ++i) o[dt][i] = 0.f;
  const float* ksrc = p.cmk + ((size_t)layer * 128 + b) * 65536;
  const float* vsrc = p.cmv + ((size_t)layer * 128 + b) * 65536;
#pragma unroll 1
  for (int c = 0; c < 4; ++c) {
    stage_f32_chunk(kimg, ksrc, c * 64, 256, nullptr, 0, 0, false);
    stage_f32_chunk(vimg, vsrc, c * 64, 256, nullptr, 0, 0, true);
    __syncthreads();
    attn_chunk(qf, kimg + w * 8192, vimg + w * 8192, m, l, o, lane, 0, 63);
    __syncthreads();
  }
  attn_store(o, l, lane, r < 8, p.act + (size_t)tok * 1024 + 768 + w * 64, p.z + (size_t)tok * ldz + gcol + w * 64);
}
DI void swa_sample(const Params& p, int b, char* smem) {
  const int lane = threadIdx.x & 63, w = threadIdx.x >> 6, r = lane & 31, h = lane >> 5;
  char* kimg = smem; char* vimg = smem + 32768;
  const int t = r & 7, g = (r >> 3) > 2 ? 2 : (r >> 3), head = w * 3 + g;
  const int tok = NPR + b * 8 + t;
  bf16x8 qf[4];
  load_q(qf, p.z + (size_t)tok * 2560 + 512 + head * 64, h);
  float m = p.sinks[head], l = h == 0 ? 1.f : 0.f;
  f32x16 o[2];
#pragma unroll
  for (int dt = 0; dt < 2; ++dt)
#pragma unroll
    for (int i = 0; i < 16; ++i) o[dt][i] = 0.f;
  const float* ksrc = p.cswk + (size_t)b * 32768;
  const float* vsrc = p.cswv + (size_t)b * 32768;
  const bf16* knew = p.z + (size_t)(NPR + b * 8) * 2560;
#pragma unroll 1
  for (int c = 0; c < 3; ++c) {
    stage_f32_chunk(kimg, ksrc, c * 64, 128, knew, 2560, 8, false);
    stage_f32_chunk(vimg, vsrc, c * 64, 128, knew + 256, 2560, 8, true);
    __syncthreads();
    attn_chunk(qf, kimg + w * 8192, vimg + w * 8192, m, l, o, lane, t + 1 - 64 * c, t + 128 - 64 * c);
    __syncthreads();
  }
  attn_store(o, l, lane, r < 24, p.act + (size_t)tok * 1024 + head * 64, p.z + (size_t)tok * 2560 + 1280 + head * 64);
}

DI void transpose_tile(const float* src, int K, int N, const float* gain, bf16* dst, int tile, char* smem) {
  float* T = (float*)smem;
  const int ntn = N >> 6, k0 = (tile / ntn) << 6, n0 = (tile % ntn) << 6, tid = threadIdx.x;
  const int c4 = tid & 15, ri = tid >> 4;
#pragma unroll
  for (int i = 0; i < 4; ++i) {
    const int k = ri + 16 * i;
    f32x4 t = *(const f32x4*)(src + (size_t)(k0 + k) * N + n0 + c4 * 4);
    const float gsc = gain ? gain[k0 + k] : 1.f;
    T[k * 65 + c4 * 4] = t[0] * gsc; T[k * 65 + c4 * 4 + 1] = t[1] * gsc; T[k * 65 + c4 * 4 + 2] = t[2] * gsc; T[k * 65 + c4 * 4 + 3] = t[3] * gsc;
  }
  __syncthreads();
  const int k8 = tid & 7, nn = tid >> 3;
#pragma unroll
  for (int i = 0; i < 2; ++i) {
    const int n = nn + 32 * i;
    const float* tp = T + (k8 * 8) * 65 + n;
    u32x4 o = {pack2(tp[0], tp[65]), pack2(tp[130], tp[195]), pack2(tp[260], tp[325]), pack2(tp[390], tp[455])};
    *(u32x4*)(dst + (size_t)(n0 + n) * K + k0 + k8 * 8) = o;
  }
  __syncthreads();
}
DI void row_prep(const float* src, bf16* dst, float* rstd, int lane) {
  float ss = 0.f;
  f32x4 t[4];
#pragma unroll
  for (int i = 0; i < 4; ++i) { t[i] = *(const f32x4*)(src + i * 256 + lane * 4); ss += t[i][0] * t[i][0] + t[i][1] * t[i][1] + t[i][2] * t[i][2] + t[i][3] * t[i][3]; }
#pragma unroll
  for (int o = 32; o > 0; o >>= 1) ss += __shfl_xor(ss, o);
#pragma unroll
  for (int i = 0; i < 4; ++i) { u32x2 ov = {pack2(t[i][0], t[i][1]), pack2(t[i][2], t[i][3])}; *(u32x2*)(dst + i * 256 + lane * 4) = ov; }
  if (lane == 0) *rstd = rsqrtf(ss * (1.f / 1024.f) + EPS);
}

template <int PH>
DI void run_phase(const Params& p, char* smem) {
  const int bid = blockIdx.x, nb = gridDim.x, tid = threadIdx.x;
  if constexpr (PH == 0) {
#pragma unroll 1
    for (int u = bid; u < 1956; u += nb) {
      int t = u;
      if (t < 512) { transpose_tile(p.w_in_a, 1024, 2048, p.norm_a, p.Wt_in_a, t, smem); continue; } t -= 512;
      if (t < 256) { transpose_tile(p.w_out_a, 1024, 1024, nullptr, p.Wt_out_a, t, smem); continue; } t -= 256;
      if (t < 128) { transpose_tile(p.w_kv, 1024, 512, p.kv_norm, p.Wt_kvb, t, smem); continue; } t -= 128;
      if (t < 512) { transpose_tile(p.w_in_b, 1024, 2048, p.norm_b, p.Wt_kvb + 512 * 1024, t, smem); continue; } t -= 512;
      if (t < 256) { transpose_tile(p.w_out_b, 1024, 1024, nullptr, p.Wt_out_b, t, smem); continue; } t -= 256;
      if (t < 256) { const int l = t >> 7; transpose_tile(p.w_mem_kv + (size_t)l * 1024 * 512, 1024, 512, p.mem_norm + l * 1024, p.Wt_mem + (size_t)l * 512 * 1024, t & 127, smem); continue; } t -= 256;
      { const int g = t / 9; transpose_tile(p.pool_mix_w + (size_t)g * 192 * 192, 192, 192, nullptr, p.Wt_pool + (size_t)g * 192 * 192, t % 9, smem); }
    }
    const int lane = tid & 63, w = tid >> 6;
#pragma unroll 1
    for (int u = bid; u < (NTOK + 256) / 4; u += nb) {
      const int row = u * 4 + w;
      if (row < NTOK) row_prep(xrow(p, row), p.xb + (size_t)row * 1024, p.rstd_a + row, lane);
      else row_prep(p.memp + (size_t)(row - NTOK) * 1024, p.memb + (size_t)(row - NTOK) * 1024, p.rstd_mem + (row - NTOK), lane);
    }
    for (int i = bid * 256 + tid; i < NTOK; i += nb * 256) p.ssq1[i] = 0.f;
    for (int i = bid * 256 + tid; i < 128 * 7 * 192; i += nb * 256) {
      const int b = i / (7 * 192), rem = i % (7 * 192);
      *(f32x4*)(p.out + O_POOLS + (size_t)b * 15 * 768 + rem * 4) = *(const f32x4*)(p.state_pool + (size_t)b * 15 * 768 + 8 * 768 + rem * 4);
    }
    for (int i = bid * 256 + tid; i < 128 * 120 * 64; i += nb * 256) {
      const int b = i / (120 * 64), rem = i % (120 * 64);
      *(f32x4*)(p.out + O_SKS + (size_t)b * 32768 + rem * 4) = *(const f32x4*)(p.cswk + (size_t)b * 32768 + 8 * 256 + rem * 4);
      *(f32x4*)(p.out + O_SVS + (size_t)b * 32768 + rem * 4) = *(const f32x4*)(p.cswv + (size_t)b * 32768 + 8 * 256 + rem * 4);
    }
  } else if constexpr (PH == 1) {
#pragma unroll 1
    for (int u = bid; u < 2176; u += nb) gemm_tile<128>(p.xb, 1024, p.Wt_in_a, 1024, 1024, (u >> 4) * 128, (u & 15) * 128, smem, EpiInA{p});
#pragma unroll 1
    for (int v = (bid + nb - (128 % nb)) % nb; v < 16; v += nb) gemm_tile<128>(p.memb, 1024, p.Wt_mem, 1024, 1024, (v >> 3) * 128, (v & 7) * 128, smem, EpiMemKV{p});
  } else if constexpr (PH == 2) {
#pragma unroll 1
    for (int u = bid; u < 512; u += nb) mem_attn_prompt(p, 0, u, smem);
#pragma unroll 1
    for (int u = bid; u < 128; u += nb) mem_attn_sample(p, 0, u, smem);
    bf16* dbuf = p.xb;
    for (int idx = bid * 256 + tid; idx < NTOK * 96; idx += nb * 256) {
      const int tok = idx / 96, c0 = (idx % 96) * 8, g = c0 / 192, wlen = 2 << g;
      float a[8];
#pragma unroll
      for (int j = 0; j < 8; ++j) a[j] = 0.f;
      float cnt;
      const u32x4 u0 = *(const u32x4*)(p.z + (size_t)tok * 2048 + c0);
      if (tok < NPR) {
        const int nr = tok + 1 < wlen ? tok + 1 : wlen;
        cnt = (float)nr;
        for (int j = 0; j < nr; ++j) {
          const u32x4 t = *(const u32x4*)(p.z + (size_t)(tok - j) * 2048 + c0);
#pragma unroll
          for (int e = 0; e < 4; ++e) { a[2 * e] += bflo(t[e]); a[2 * e + 1] += bfhi(t[e]); }
        }
      } else {
        const int s = tok - NPR, b = s >> 3, t8 = s & 7;
        cnt = (float)wlen;
        for (int j = 0; j < wlen; ++j) {
          const int tt = t8 - j;
          if (tt >= 0) {
            const u32x4 t = *(const u32x4*)(p.z + (size_t)(tok - j) * 2048 + c0);
#pragma unroll
            for (int e = 0; e < 4; ++e) { a[2 * e] += bflo(t[e]); a[2 * e + 1] += bfhi(t[e]); }
          } else {
            const float* sp = p.state_pool + (size_t)(b * 15 + 15 + tt) * 768 + c0;
            const f32x4 x0 = *(const f32x4*)sp, x1 = *(const f32x4*)(sp + 4);
            a[0] += x0[0]; a[1] += x0[1]; a[2] += x0[2]; a[3] += x0[3]; a[4] += x1[0]; a[5] += x1[1]; a[6] += x1[2]; a[7] += x1[3];
          }
        }
      }
      const float ic = 1.f / cnt;
      u32x4 o;
#pragma unroll
      for (int e = 0; e < 4; ++e) o[e] = pack2(a[2 * e] * ic - bflo(u0[e]), a[2 * e + 1] * ic - bfhi(u0[e]));
      *(u32x4*)(dbuf + (size_t)tok * 768 + c0) = o;
    }
  } else if constexpr (PH == 3) {
#pragma unroll 1
    for (int u = bid; u < 136 * 12; u += nb) {
      const int mt = u / 12, rem = u % 12, g = rem / 3, nt = rem % 3;
      gemm_tile<64>(p.xb + g * 192, 768, p.Wt_pool + (size_t)g * 192 * 192, 192, 192, mt * 128, nt * 64, smem, EpiPool{p, g});
    }
  } else if constexpr (PH == 4) {
#pragma unroll 1
    for (int u = bid; u < 136 * 8; u += nb) gemm_tile<128>(p.act, 1024, p.Wt_out_a, 1024, 1024, (u >> 3) * 128, (u & 7) * 128, smem, EpiOutA{p});
  } else if constexpr (PH == 5) {
#pragma unroll 1
    for (int u = bid; u < 136 * 20; u += nb) gemm_tile<128>(p.xb, 1024, p.Wt_kvb, 1024, 1024, (u / 20) * 128, (u % 20) * 128, smem, EpiKVB{p});
  } else if constexpr (PH == 6) {
#pragma unroll 1
    for (int u = bid; u < 512; u += nb) swa_prompt(p, u, smem);
#pragma unroll 1
    for (int u = bid; u < 512; u += nb) mem_attn_prompt(p, 1, u, smem);
#pragma unroll 1
    for (int u = bid; u < 128; u += nb) swa_sample(p, u, smem);
#pragma unroll 1
    for (int u = (bid + nb - (128 % nb)) % nb; u < 128; u += nb) mem_attn_sample(p, 1, u, smem);
  } else if constexpr (PH == 7) {
#pragma unroll 1
    for (int u = bid; u < 136 * 8; u += nb) gemm_tile<128>(p.act, 1024, p.Wt_out_b, 1024, 1024, (u >> 3) * 128, (u & 7) * 128, smem, EpiOutB{p});
  }
}

#if MULTI_LAUNCH
template <int PH>
__global__ void __launch_bounds__(256, 2) phase_kernel(Params p) {
  __shared__ __attribute__((aligned(16))) char smem[65536];
  run_phase<PH>(p, smem);
}
#else
__global__ void __launch_bounds__(256, 2) yoco_megakernel(Params p) {
  __shared__ __attribute__((aligned(16))) char smem[65536];
  cg::grid_group grid = cg::this_grid();
  run_phase<0>(p, smem); grid.sync();
  run_phase<1>(p, smem); grid.sync();
  run_phase<2>(p, smem); grid.sync();
  run_phase<3>(p, smem); grid.sync();
  run_phase<4>(p, smem); grid.sync();
  run_phase<5>(p, smem); grid.sync();
  run_phase<6>(p, smem); grid.sync();
  run_phase<7>(p, smem);
}
#endif

extern "C" void kernel_launch(void* const* d_in, const int* in_sizes, int n_in, void* d_out, int out_size, void* d_ws, size_t ws_size, hipStream_t stream) {
  Params p{};
  const float* const* in = (const float* const*)d_in;
  p.xp = in[0]; p.xs = in[1]; p.state_pool = in[2]; p.cswk = in[3]; p.cswv = in[4]; p.cmk = in[5]; p.cmv = in[6]; p.memp = in[7];
  p.norm_a = in[8]; p.w_in_a = in[9]; p.pool_mix_w = in[10]; p.pool_scale = in[11]; p.w_out_a = in[12]; p.kv_norm = in[13]; p.w_kv = in[14];
  p.k_norm = in[15]; p.norm_b = in[16]; p.w_in_b = in[17]; p.q_norm = in[18]; p.sinks = in[19]; p.w_out_b = in[20]; p.mem_norm = in[21];
  p.w_mem_kv = in[22]; p.mem_q_norm = in[23]; p.mem_k_norm = in[24];
  p.out = (float*)d_out;
  char* ws = (char*)d_ws;
  size_t off = 0;
  auto take = [&](size_t bytes) { char* r = ws + off; off += (bytes + 255) & ~(size_t)255; return r; };
  p.Wt_in_a = (bf16*)take((size_t)2048 * 1024 * 2);
  p.Wt_out_a = (bf16*)take((size_t)1024 * 1024 * 2);
  p.Wt_kvb = (bf16*)take((size_t)2560 * 1024 * 2);
  p.Wt_out_b = (bf16*)take((size_t)1024 * 1024 * 2);
  p.Wt_mem = (bf16*)take((size_t)1024 * 1024 * 2);
  p.Wt_pool = (bf16*)take((size_t)4 * 192 * 192 * 2);
  p.memb = (bf16*)take((size_t)256 * 1024 * 2);
  p.mkb = (bf16*)take((size_t)4 * 256 * 256 * 2);
  p.rstd_a = (float*)take((size_t)NTOK * 4);
  p.rstd_mem = (float*)take(256 * 4);
  p.ssq1 = (float*)take((size_t)NTOK * 4);
  p.xb = (bf16*)take((size_t)NTOK * 1024 * 2);
  p.act = (bf16*)take((size_t)NTOK * 1024 * 2);
  p.z = (bf16*)take((size_t)NTOK * 2560 * 2);
  for (int i = 0; i < 8; ++i) p.rope_inv[i] = powf(500000.0f, -(float)i / 8.0f);
#if MULTI_LAUNCH
  const int grid = 512;
  phase_kernel<0><<<grid, 256, 0, stream>>>(p);
  phase_kernel<1><<<grid, 256, 0, stream>>>(p);
  phase_kernel<2><<<grid, 256, 0, stream>>>(p);
  phase_kernel<3><<<grid, 256, 0, stream>>>(p);
  phase_kernel<4><<<grid, 256, 0, stream>>>(p);
  phase_kernel<5><<<grid, 256, 0, stream>>>(p);
  phase_kernel<6><<<grid, 256, 0, stream>>>(p);
  phase_kernel<7><<<grid, 256, 0, stream>>>(p);
#else
  static int grid_blocks = 0;
  if (!grid_blocks) {
    int dev = 0, cus = 0, per_cu = 0;
    hipGetDevice(&dev);
    hipDeviceGetAttribute(&cus, hipDeviceAttributeMultiprocessorCount, dev);
    hipOccupancyMaxActiveBlocksPerMultiprocessor(&per_cu, yoco_megakernel, 256, 0);
    if (per_cu > 2) per_cu = 2;
    grid_blocks = cus * per_cu;
  }
  void* args[] = {&p};
  hipError_t e = hipLaunchCooperativeKernel((void*)yoco_megakernel, dim3(grid_blocks), dim3(256), args, 0, stream);
  if (e != hipSuccess) fprintf(stderr, "cooperative launch failed: %s (grid %d)\n", hipGetErrorString(e), grid_blocks);
#endif
}
```

```cpp
#include <hip/hip_runtime.h>
#include <hip/hip_cooperative_groups.h>
#include <cstdio>
#include <cmath>
namespace cg = cooperative_groups;

#ifndef MULTI_LAUNCH
#define MULTI_LAUNCH 0
#endif

typedef unsigned short bf16;
typedef short bf16x8 __attribute__((ext_vector_type(8)));
typedef short s16x4 __attribute__((ext_vector_type(4)));
typedef float f32x16 __attribute__((ext_vector_type(16)));
typedef float f32x4 __attribute__((ext_vector_type(4)));
typedef unsigned u32x4 __attribute__((ext_vector_type(4)));
typedef unsigned u32x2 __attribute__((ext_vector_type(2)));
#define DI __device__ __forceinline__
#define MFMA32(a, b, c) __builtin_amdgcn_mfma_f32_32x32x16_bf16((a), (b), (c), 0, 0, 0)

constexpr int NTOK = 17408, NPR = 16384, DM = 1024;
constexpr float EPS = 1e-6f;
constexpr float LOG2E = 1.4426950408889634f;
constexpr size_t O_Y = 0, O_POOLP = 17825792, O_POOLS = 17837312, O_SKP = 19311872, O_SVP = 19344640,
                 O_SKS = 19377408, O_SVS = 23571712, O_MKP = 27766016, O_MVP = 27897088;

struct Params {
  const float *xp, *xs, *state_pool, *cswk, *cswv, *cmk, *cmv, *memp;
  const float *norm_a, *w_in_a, *pool_mix_w, *pool_scale, *w_out_a, *kv_norm, *w_kv, *k_norm, *norm_b, *w_in_b, *q_norm,
      *sinks, *w_out_b, *mem_norm, *w_mem_kv, *mem_q_norm, *mem_k_norm;
  float* out;
  bf16 *Wt_in_a, *Wt_out_a, *Wt_kvb, *Wt_out_b, *Wt_mem, *Wt_pool;
  bf16 *xb, *act, *z, *memb, *mkb, *dbuf;
  float *rstd_a, *rstd_mem, *ssq1;
  unsigned* bar;
  float rope_inv[8];
};

DI unsigned pack2(float a, float b) {
  typedef __bf16 bf2 __attribute__((ext_vector_type(2)));
  typedef float f2 __attribute__((ext_vector_type(2)));
  f2 f = {a, b};
  return __builtin_bit_cast(unsigned, __builtin_convertvector(f, bf2));
}
DI float bflo(unsigned u) { return __uint_as_float(u << 16); }
DI float bfhi(unsigned u) { return __uint_as_float(u & 0xffff0000u); }
DI float silu(float x) { return x * __builtin_amdgcn_rcpf(1.f + __builtin_amdgcn_exp2f(-LOG2E * x)); }
DI int crow(int i, int h) { return (i & 3) + 8 * (i >> 2) + 4 * h; }
DI const float* xrow(const Params& p, int tok) { return tok < NPR ? p.xp + (size_t)tok * DM : p.xs + (size_t)(tok - NPR) * DM; }

template <int MI, int NI>
DI void frag_read(u32x4 (&fa)[MI], u32x4 (&fb)[NI], unsigned ab, unsigned bb) {
  if constexpr (MI == 4 && NI == 2) {
    asm volatile("ds_read_b128 %0, %6\n\tds_read_b128 %1, %6 offset:2048\n\tds_read_b128 %2, %6 offset:4096\n\tds_read_b128 %3, %6 offset:6144\n\t"
                 "ds_read_b128 %4, %7\n\tds_read_b128 %5, %7 offset:2048"
                 : "=&v"(fa[0]), "=&v"(fa[1]), "=&v"(fa[2]), "=&v"(fa[3]), "=&v"(fb[0]), "=&v"(fb[1]) : "v"(ab), "v"(bb) : "memory");
  } else {
    static_assert((MI == 4 && NI == 2) || (MI == 2 && NI == 1), "tile config");
    asm volatile("ds_read_b128 %0, %3\n\tds_read_b128 %1, %3 offset:2048\n\tds_read_b128 %2, %4"
                 : "=&v"(fa[0]), "=&v"(fa[1]), "=&v"(fb[0]) : "v"(ab), "v"(bb) : "memory");
  }
}
template <int KEEP, int MI, int NI>
DI void frag_wait(u32x4 (&fa)[MI], u32x4 (&fb)[NI]) {
  if constexpr (MI == 4 && NI == 2)
    asm volatile("s_waitcnt lgkmcnt(%6)" : "+v"(fa[0]), "+v"(fa[1]), "+v"(fa[2]), "+v"(fa[3]), "+v"(fb[0]), "+v"(fb[1]) : "n"(KEEP) : "memory");
  else
    asm volatile("s_waitcnt lgkmcnt(%3)" : "+v"(fa[0]), "+v"(fa[1]), "+v"(fb[0]) : "n"(KEEP) : "memory");
}
template <int BM, int BN, class Epi>
DI void gemm_tile(const bf16* __restrict__ A, int lda, const bf16* __restrict__ Bt, int ldb, int nk64, int m0, int n0, char* smem, const Epi& epi) {
  constexpr int RW = BM / 2, CW = BN / 4, MI = RW / 32, NI = CW / 32;
  constexpr int A_BYTES = BM * 64, B_BYTES = BN * 64, STAGE = A_BYTES + B_BYTES, GA = BM / 128, GB = BN / 128, GT = GA + GB;
  const int nk = nk64 * 2;
  const int tid = threadIdx.x, lane = tid & 63, w = tid >> 6;
  const int wm = w >> 2, wn = w & 3, r = lane & 31, h = lane >> 5;
  f32x16 acc[MI][NI];
#pragma unroll
  for (int mi = 0; mi < MI; ++mi)
#pragma unroll
    for (int ni = 0; ni < NI; ++ni)
#pragma unroll
      for (int i = 0; i < 16; ++i) acc[mi][ni][i] = 0.f;
  const int srow = w * 16 + (lane >> 2);
  const int slc = (lane & 3) ^ ((srow >> 2) & 3);
  const bf16* Ag = A + (size_t)(m0 + srow) * lda + slc * 8;
  const bf16* Bg = Bt + (size_t)(n0 + srow) * ldb + slc * 8;
#define GEMM_STAGE(buf, kt)                                                                                                        \
  do {                                                                                                                             \
    char* sa_ = smem + (buf) * STAGE + w * 1024;                                                                                   \
    _Pragma("unroll") for (int i = 0; i < GA; ++i)                                                                                 \
        __builtin_amdgcn_global_load_lds((const unsigned*)(Ag + (size_t)(128 * i) * lda + (kt) * 32), (unsigned*)(sa_ + i * 8192), 16, 0, 0); \
    _Pragma("unroll") for (int i = 0; i < GB; ++i)                                                                                 \
        __builtin_amdgcn_global_load_lds((const unsigned*)(Bg + (size_t)(128 * i) * ldb + (kt) * 32), (unsigned*)(sa_ + A_BYTES + i * 8192), 16, 0, 0); \
  } while (0)
#define WAIT_V(n) asm volatile("s_waitcnt vmcnt(%0)" ::"n"(n) : "memory")
  asm volatile("s_waitcnt vmcnt(0)" ::: "memory");
  GEMM_STAGE(0, 0);
  GEMM_STAGE(1, 1);
  GEMM_STAGE(2, 2);
  int aoff[MI], boff[NI];
#pragma unroll
  for (int mi = 0; mi < MI; ++mi) { const int row = wm * RW + mi * 32 + r; aoff[mi] = row * 64 + ((h ^ ((row >> 2) & 3)) << 4); }
#pragma unroll
  for (int ni = 0; ni < NI; ++ni) { const int row = wn * CW + ni * 32 + r; boff[ni] = A_BYTES + row * 64 + ((h ^ ((row >> 2) & 3)) << 4); }
  constexpr int RD = MI + NI;
  const unsigned sb0 = (unsigned)(size_t)smem;
  u32x4 fa0[MI], fb0[NI], fa1[MI], fb1[NI];
#define GEMM_MMA(FA, FB)                                                                                   \
  _Pragma("unroll") for (int mi = 0; mi < MI; ++mi) _Pragma("unroll") for (int ni = 0; ni < NI; ++ni)      \
      acc[mi][ni] = MFMA32(__builtin_bit_cast(bf16x8, FB[ni]), __builtin_bit_cast(bf16x8, FA[mi]), acc[mi][ni])
  WAIT_V(2 * GT);
  __builtin_amdgcn_s_barrier();
  asm volatile("" ::: "memory");
  frag_read<MI, NI>(fa0, fb0, sb0 + (unsigned)aoff[0], sb0 + (unsigned)boff[0]);
#pragma unroll 1
  for (int kt = 0; kt < nk - 1; ++kt) {
    if (kt + 2 < nk) WAIT_V(GT); else WAIT_V(0);
    __builtin_amdgcn_s_barrier();
    asm volatile("" ::: "memory");
    if (kt + 3 < nk) GEMM_STAGE((kt + 3) & 3, kt + 3);
    const unsigned sc = sb0 + (unsigned)((kt & 3) * STAGE), sn = sb0 + (unsigned)(((kt + 1) & 3) * STAGE);
    frag_read<MI, NI>(fa1, fb1, (sc + (unsigned)aoff[0]) ^ 32u, (sc + (unsigned)boff[0]) ^ 32u);
    frag_wait<RD, MI, NI>(fa0, fb0);
    GEMM_MMA(fa0, fb0);
    frag_read<MI, NI>(fa0, fb0, sn + (unsigned)aoff[0], sn + (unsigned)boff[0]);
    frag_wait<RD, MI, NI>(fa1, fb1);
    GEMM_MMA(fa1, fb1);
  }
  {
    const unsigned sc = sb0 + (unsigned)(((nk - 1) & 3) * STAGE);
    frag_read<MI, NI>(fa1, fb1, (sc + (unsigned)aoff[0]) ^ 32u, (sc + (unsigned)boff[0]) ^ 32u);
    frag_wait<RD, MI, NI>(fa0, fb0);
    GEMM_MMA(fa0, fb0);
    frag_wait<0, MI, NI>(fa1, fb1);
    GEMM_MMA(fa1, fb1);
  }
#undef GEMM_MMA
#undef GEMM_STAGE
#undef WAIT_V
  __syncthreads();
  constexpr int CPB = (BN + 8) * 2, SEGS = BN / 32, ITEMS = BM * SEGS / 512;
#pragma unroll
  for (int mi = 0; mi < MI; ++mi)
#pragma unroll
    for (int ni = 0; ni < NI; ++ni)
#pragma unroll
      for (int g = 0; g < 4; ++g) {
        const int row = wm * RW + mi * 32 + r, col = wn * CW + ni * 32 + 8 * g + 4 * h;
        u32x2 pk = {pack2(acc[mi][ni][4 * g], acc[mi][ni][4 * g + 1]), pack2(acc[mi][ni][4 * g + 2], acc[mi][ni][4 * g + 3])};
        *(u32x2*)(smem + row * CPB + col * 2) = pk;
      }
  __syncthreads();
  typename Epi::Pre pre[ITEMS];
#pragma unroll
  for (int it = 0; it < ITEMS; ++it) {
    const int item = it * 512 + tid, prow = item / SEGS, seg = item % SEGS;
    epi.prefetch(m0 + prow, n0 + seg * 32, pre[it]);
  }
#pragma unroll
  for (int it = 0; it < ITEMS; ++it) {
    const int item = it * 512 + tid, prow = item / SEGS, seg = item % SEGS;
    float v[32];
#pragma unroll
    for (int j = 0; j < 4; ++j) {
      const u32x4 t = *(const u32x4*)(smem + prow * CPB + seg * 64 + 16 * j);
#pragma unroll
      for (int e = 0; e < 4; ++e) { v[8 * j + 2 * e] = bflo(t[e]); v[8 * j + 2 * e + 1] = bfhi(t[e]); }
    }
    epi(m0 + prow, n0 + seg * 32, v, pre[it]);
  }
  __syncthreads();
}
template <class Epi>
DI void gemm_phase(const bf16* A, int lda, const bf16* Bt, int ldb, int nk, int MT, int NT, char* smem, const Epi& epi, int g_vb) {
  const int nb = gridDim.x;
  const int vb = g_vb;
  const int U = MT * NT, full = (U / nb) * nb, rem = U - full;
#pragma unroll 1
  for (int u = vb; u < full; u += nb) gemm_tile<256, 256>(A, lda, Bt, ldb, nk, (u / NT) * 256, (u % NT) * 256, smem, epi);
  if (rem * 4 <= nb) {
    const int tvb = (nb & 255) == 0 ? ((vb & 31) * (nb >> 5) + (vb >> 5)) : vb;
#pragma unroll 1
    for (int sidx = tvb; sidx < rem * 4; sidx += nb) {
      const int u = full + (sidx >> 2), q = sidx & 3;
      gemm_tile<128, 128>(A, lda, Bt, ldb, nk, (u / NT) * 256 + (q >> 1) * 128, (u % NT) * 256 + (q & 1) * 128, smem, epi);
    }
  } else {
#pragma unroll 1
    for (int u = full + vb; u < U; u += nb) gemm_tile<256, 256>(A, lda, Bt, ldb, nk, (u / NT) * 256, (u % NT) * 256, smem, epi);
  }
}

template <int NC>
DI void store_bf16(bf16* dst, const float (&v)[NC]) {
#pragma unroll
  for (int j = 0; j < NC / 8; ++j) {
    u32x4 o = {pack2(v[8 * j], v[8 * j + 1]), pack2(v[8 * j + 2], v[8 * j + 3]), pack2(v[8 * j + 4], v[8 * j + 5]), pack2(v[8 * j + 6], v[8 * j + 7])};
    *(u32x4*)(dst + 8 * j) = o;
  }
}
template <int NC>
DI void store_f32(float* dst, const float (&v)[NC]) {
#pragma unroll
  for (int j = 0; j < NC / 4; ++j) { f32x4 o = {v[4 * j], v[4 * j + 1], v[4 * j + 2], v[4 * j + 3]}; *(f32x4*)(dst + 4 * j) = o; }
}
DI void head_rmsnorm(float (&v)[32], const float* gain, int hoff, float post) {
  float ss = 0.f;
#pragma unroll
  for (int j = 0; j < 32; ++j) ss += v[j] * v[j];
  ss += __shfl_xor(ss, 1);
  const float rs = rsqrtf(ss * (1.f / 64.f) + EPS) * post;
#pragma unroll
  for (int j = 0; j < 32; ++j) v[j] = v[j] * rs * gain[hoff + j];
}
DI void rope16(float (&v)[32], int pos, const float* inv) {
#pragma unroll
  for (int i = 0; i < 8; ++i) {
    double rev = (double)pos * (double)inv[i] * 0.15915494309189535;
    rev -= floor(rev);
    const float fr = (float)rev;
    const float sn = __builtin_amdgcn_sinf(fr), cs = __builtin_amdgcn_cosf(fr);
    const float a = v[i], b = v[i + 8];
    v[i] = a * cs - b * sn;
    v[i + 8] = b * cs + a * sn;
  }
}

struct EpiInA {
  const Params& p;
  struct Pre { float rs; };
  DI void prefetch(int row, int col, Pre& q) const { q.rs = p.rstd_a[row]; }
  DI void operator()(int row, int col, float (&v)[32], const Pre& q) const {
    const float rs = q.rs;
#pragma unroll
    for (int j = 0; j < 32; ++j) v[j] *= rs;
    if (col < 768) {
      if (row >= NPR - 15) {
        if (row < NPR) store_f32<32>(p.out + O_POOLP + (size_t)(row - (NPR - 15)) * 768 + col, v);
        else { const int s = row - NPR, b = s >> 3, t = s & 7; store_f32<32>(p.out + O_POOLS + (size_t)(b * 15 + 7 + t) * 768 + col, v); }
      }
    } else if (col < 1536) {
#pragma unroll
      for (int j = 0; j < 32; ++j) v[j] = silu(v[j]);
    } else if (col < 1792) {
      head_rmsnorm(v, p.mem_q_norm, col & 63, 0.125f * LOG2E);
    } else {
#pragma unroll
      for (int j = 0; j < 32; ++j) v[j] = silu(v[j]);
    }
    store_bf16<32>(p.z + (size_t)row * 2048 + col, v);
  }
};
struct EpiMemKV {
  const Params& p;
  struct Pre { float rs; };
  DI void prefetch(int row, int col, Pre& q) const { q.rs = p.rstd_mem[row]; }
  DI void operator()(int row, int col, float (&v)[32], const Pre& q) const {
    const float rs = q.rs;
#pragma unroll
    for (int j = 0; j < 32; ++j) v[j] *= rs;
    const int l = col >> 9, wi = col & 511;
    const bool isk = wi < 256;
    if (isk) head_rmsnorm(v, p.mem_k_norm + l * 64, col & 63, 1.f);
    const size_t e = (size_t)(l * 256 + row) * 256 + (wi & 255) + (isk ? 0 : 131072);
    store_f32<32>(p.out + O_MKP + e, v);
    store_bf16<32>(p.mkb + e, v);
  }
};
struct EpiPool {
  const Params& p;
  struct Pre { u32x4 g[4]; };
  DI void prefetch(int row, int col, Pre& pq) const {
    const bf16* gp = p.z + (size_t)row * 2048 + 768 + col;
#pragma unroll
    for (int q = 0; q < 4; ++q) pq.g[q] = *(const u32x4*)(gp + 8 * q);
  }
  DI void operator()(int row, int col, float (&v)[32], const Pre& pq) const {
    const float* sc = p.pool_scale + col;
#pragma unroll
    for (int q = 0; q < 4; ++q) {
      const u32x4 g = pq.g[q];
#pragma unroll
      for (int j = 0; j < 4; ++j) { v[8 * q + 2 * j] *= sc[8 * q + 2 * j] * bflo(g[j]); v[8 * q + 2 * j + 1] *= sc[8 * q + 2 * j + 1] * bfhi(g[j]); }
    }
    store_bf16<32>(p.act + (size_t)row * 1024 + col, v);
  }
};
struct EpiOutA {
  const Params& p;
  struct Pre { u32x4 x[4]; };
  DI void prefetch(int row, int col, Pre& q) const {
    const bf16* xr = p.xb + (size_t)row * 1024 + col;
#pragma unroll
    for (int j = 0; j < 4; ++j) q.x[j] = *(const u32x4*)(xr + 8 * j);
  }
  DI void operator()(int row, int col, float (&v)[32], const Pre& q) const {
    float ss = 0.f;
#pragma unroll
    for (int j = 0; j < 4; ++j)
#pragma unroll
      for (int e = 0; e < 4; ++e) { v[8 * j + 2 * e] += bflo(q.x[j][e]); v[8 * j + 2 * e + 1] += bfhi(q.x[j][e]); }
#pragma unroll
    for (int j = 0; j < 32; ++j) ss += v[j] * v[j];
    ss += __shfl_xor(ss, 1);
    ss += __shfl_xor(ss, 2);
    if ((threadIdx.x & 3) == 0) atomicAdd(p.ssq1 + row, ss);
    store_bf16<32>(p.xb + (size_t)row * 1024 + col, v);
  }
};
struct EpiKVB {
  const Params& p;
  struct Pre { float ssq; };
  DI void prefetch(int row, int col, Pre& q) const { q.ssq = p.ssq1[row]; }
  DI void operator()(int row, int col, float (&v)[32], const Pre& q) const {
    const float rs = rsqrtf(q.ssq * (1.f / 1024.f) + EPS);
#pragma unroll
    for (int j = 0; j < 32; ++j) v[j] *= rs;
    const int pos = row < NPR ? row : NPR + ((row - NPR) & 7);
    if (col < 512) {
      if (col < 256) {
        head_rmsnorm(v, p.k_norm, col & 63, 1.f);
        if ((col & 63) == 0) rope16(v, pos, p.rope_inv);
      }
      const size_t ob = col < 256 ? 0 : (O_SVP - O_SKP);
      const size_t obs = col < 256 ? 0 : (O_SVS - O_SKS);
      const int c = col & 255;
      if (row >= NPR - 128) {
        if (row < NPR) store_f32<32>(p.out + O_SKP + ob + (size_t)(row - (NPR - 128)) * 256 + c, v);
        else { const int s = row - NPR, b = s >> 3, t = s & 7; store_f32<32>(p.out + O_SKS + obs + (size_t)(b * 128 + 120 + t) * 256 + c, v); }
      }
    } else if (col < 1280) {
      head_rmsnorm(v, p.q_norm, col & 63, 0.125f * LOG2E);
      if ((col & 63) == 0) rope16(v, pos, p.rope_inv);
    } else if (col < 2048) {
#pragma unroll
      for (int j = 0; j < 32; ++j) v[j] = silu(v[j]);
    } else if (col < 2304) {
      head_rmsnorm(v, p.mem_q_norm + 64, col & 63, 0.125f * LOG2E);
    } else {
#pragma unroll
      for (int j = 0; j < 32; ++j) v[j] = silu(v[j]);
    }
    store_bf16<32>(p.z + (size_t)row * 2560 + col, v);
  }
};
struct EpiOutB {
  const Params& p;
  struct Pre { u32x4 x[4]; };
  DI void prefetch(int row, int col, Pre& q) const {
    const bf16* xr = p.xb + (size_t)row * 1024 + col;
#pragma unroll
    for (int j = 0; j < 4; ++j) q.x[j] = *(const u32x4*)(xr + 8 * j);
  }
  DI void operator()(int row, int col, float (&v)[32], const Pre& q) const {
#pragma unroll
    for (int j = 0; j < 4; ++j)
#pragma unroll
      for (int e = 0; e < 4; ++e) { v[8 * j + 2 * e] += bflo(q.x[j][e]); v[8 * j + 2 * e + 1] += bfhi(q.x[j][e]); }
    store_f32<32>(p.out + O_Y + (size_t)row * 1024 + col, v);
  }
};

template <bool MASKED>
DI void attn_chunk(const bf16x8 (&qf)[4], const char* kimg, const char* vimg, float& m, float& l, f32x16 (&o)[2], int lane, int lo, int hi) {
  const int r = lane & 31, h = lane >> 5;
  f32x16 s[2];
#pragma unroll
  for (int kt = 0; kt < 2; ++kt) {
#pragma unroll
    for (int i = 0; i < 16; ++i) s[kt][i] = 0.f;
#pragma unroll
    for (int ks = 0; ks < 4; ++ks) {
      const int row = kt * 32 + r, chunk = ks * 2 + h;
      const bf16x8 kf = *(const bf16x8*)(kimg + row * 128 + ((chunk ^ ((row >> 1) & 7)) << 4));
      s[kt] = MFMA32(kf, qf[ks], s[kt]);
    }
  }
  float mx = -1e30f;
#pragma unroll
  for (int kt = 0; kt < 2; ++kt)
#pragma unroll
    for (int i = 0; i < 16; ++i) {
      if (MASKED) {
        const int kk = kt * 32 + crow(i, h);
        const bool ok = (kk >= lo) && (kk <= hi);
        s[kt][i] = ok ? s[kt][i] : -1e30f;
      }
      mx = fmaxf(mx, s[kt][i]);
    }
  mx = fmaxf(mx, __shfl_xor(mx, 32));
  const float mn = fmaxf(m, mx);
  const float alpha = __builtin_amdgcn_exp2f(m - mn);
  m = mn;
  float ps = 0.f;
#pragma unroll
  for (int kt = 0; kt < 2; ++kt)
#pragma unroll
    for (int i = 0; i < 16; ++i) {
      const float pv = (!MASKED || s[kt][i] > -1e29f) ? __builtin_amdgcn_exp2f(s[kt][i] - mn) : 0.f;
      s[kt][i] = pv;
      ps += pv;
    }
  l = l * alpha + ps;
#pragma unroll
  for (int dt = 0; dt < 2; ++dt)
#pragma unroll
    for (int i = 0; i < 16; ++i) o[dt][i] *= alpha;
  const int i16 = lane & 15, q = i16 >> 2, pp = i16 & 3, blk = (lane >> 4) & 1;
#pragma unroll
  for (int kt = 0; kt < 2; ++kt)
#pragma unroll
    for (int st = 0; st < 2; ++st) {
      u32x4 pk = {pack2(s[kt][8 * st], s[kt][8 * st + 1]), pack2(s[kt][8 * st + 2], s[kt][8 * st + 3]),
                  pack2(s[kt][8 * st + 4], s[kt][8 * st + 5]), pack2(s[kt][8 * st + 6], s[kt][8 * st + 7])};
      const bf16x8 pf = __builtin_bit_cast(bf16x8, pk);
      const int row = kt * 32 + st * 16 + 4 * h + q;
#pragma unroll
      for (int dt = 0; dt < 2; ++dt) {
        const int cb = (dt * 32 + blk * 16 + pp * 4) * 2;
        const int a0 = row * 128 + (cb ^ (((row >> 1) & 1) << 6));
        const s16x4 lo4 = __builtin_amdgcn_ds_read_tr16_b64_v4i16((s16x4 __attribute__((address_space(3)))*)(vimg + a0));
        const s16x4 hi4 = __builtin_amdgcn_ds_read_tr16_b64_v4i16((s16x4 __attribute__((address_space(3)))*)(vimg + a0 + 8 * 128));
        const bf16x8 vf = __builtin_shufflevector(lo4, hi4, 0, 1, 2, 3, 4, 5, 6, 7);
        o[dt] = MFMA32(vf, pf, o[dt]);
      }
    }
}
DI void attn_store(const f32x16 (&o)[2], float l, int lane, bool valid, bf16* dst, const bf16* gate) {
  const int h = lane >> 5;
  const float lt = l + __shfl_xor(l, 32);
  const float inv = 1.f / lt;
  if (valid) {
#pragma unroll
    for (int dt = 0; dt < 2; ++dt)
#pragma unroll
      for (int g4 = 0; g4 < 4; ++g4) {
        const int d0 = dt * 32 + g4 * 8 + 4 * h;
        const u32x2 gg = *(const u32x2*)(gate + d0);
        u32x2 ov = {pack2(o[dt][4 * g4] * inv * bflo(gg[0]), o[dt][4 * g4 + 1] * inv * bfhi(gg[0])),
                    pack2(o[dt][4 * g4 + 2] * inv * bflo(gg[1]), o[dt][4 * g4 + 3] * inv * bfhi(gg[1]))};
        *(u32x2*)(dst + d0) = ov;
      }
  }
}
DI void load_q(bf16x8 (&qf)[4], const bf16* qrow, int h) {
#pragma unroll
  for (int ks = 0; ks < 4; ++ks) qf[ks] = *(const bf16x8*)(qrow + ks * 16 + 8 * h);
}
template <int NROWS>
DI void stage_bf16(char* img, const bf16* src, int ld, bool vimg, int zero_below) {
  const int tid = threadIdx.x;
#pragma unroll
  for (int i = 0; i < NROWS / 64; ++i) {
    const int id = tid + 512 * i, row = id >> 3, kc = id & 7;
    u32x4 t = {0u, 0u, 0u, 0u};
    if (row >= zero_below) t = *(const u32x4*)(src + (ptrdiff_t)row * ld + kc * 8);
    const int sw = vimg ? (kc ^ (((row >> 1) & 1) << 2)) : (kc ^ ((row >> 1) & 7));
    *(u32x4*)(img + row * 128 + (sw << 4)) = t;
  }
}

DI void mem_attn_prompt(const Params& p, int layer, int unit, char* smem) {
  const int tt = unit >> 2, hh = unit & 3;
  const int lane = threadIdx.x & 63, w = threadIdx.x >> 6, r = lane & 31, h = lane >> 5;
  const int ldz = layer ? 2560 : 2048, qcol = layer ? 2048 : 1536, gcol = layer ? 2304 : 1792;
  char* kimg = smem; char* vimg = smem + 32768;
  stage_bf16<256>(kimg, p.mkb + (size_t)layer * 65536 + hh * 64, 256, false, 0);
  stage_bf16<256>(vimg, p.mkb + 131072 + (size_t)layer * 65536 + hh * 64, 256, true, 0);
  const int tok = tt * 256 + w * 32 + r;
  bf16x8 qf[4];
  load_q(qf, p.z + (size_t)tok * ldz + qcol + hh * 64, h);
  __syncthreads();
  float m = -1e30f, l = 0.f;
  f32x16 o[2];
#pragma unroll
  for (int dt = 0; dt < 2; ++dt)
#pragma unroll
    for (int i = 0; i < 16; ++i) o[dt][i] = 0.f;
#pragma unroll 1
  for (int c = 0; c < 4; ++c) attn_chunk<false>(qf, kimg + c * 8192, vimg + c * 8192, m, l, o, lane, 0, 63);
  attn_store(o, l, lane, true, p.act + (size_t)tok * 1024 + 768 + hh * 64, p.z + (size_t)tok * ldz + gcol + hh * 64);
  __syncthreads();
}
DI void swa_prompt(const Params& p, int unit, char* smem) {
  const int n = unit >> 2, kvh = unit & 3;
  const int lane = threadIdx.x & 63, w = threadIdx.x >> 6, r = lane & 31, h = lane >> 5;
  char* kimg = smem; char* vimg = smem + 49152;
  const bf16* kv0 = p.z + (ptrdiff_t)(n * 256 - 128) * 2560 + kvh * 64;
  const int zb = n == 0 ? 128 : 0;
  stage_bf16<384>(kimg, kv0, 2560, false, zb);
  stage_bf16<384>(vimg, kv0 + 256, 2560, true, zb);
  __syncthreads();
  const int t = w * 32 + r, tok = n * 256 + t;
  const int klo = (n == 0 && t + 1 < 128) ? 128 : t + 1, khi = t + 128;
  const int c0 = (32 * w + 1) >> 6, c1 = (32 * w + 159) >> 6;
#pragma unroll 1
  for (int g = 0; g < 3; ++g) {
    const int head = kvh * 3 + g;
    bf16x8 qf[4];
    load_q(qf, p.z + (size_t)tok * 2560 + 512 + head * 64, h);
    float m = p.sinks[head] * LOG2E, l = h == 0 ? 1.f : 0.f;
    f32x16 o[2];
#pragma unroll
    for (int dt = 0; dt < 2; ++dt)
#pragma unroll
      for (int i = 0; i < 16; ++i) o[dt][i] = 0.f;
#pragma unroll 1
    for (int c = c0; c <= c1; ++c) attn_chunk<true>(qf, kimg + c * 8192, vimg + c * 8192, m, l, o, lane, klo - 64 * c, khi - 64 * c);
    attn_store(o, l, lane, true, p.act + (size_t)tok * 1024 + head * 64, p.z + (size_t)tok * 2560 + 1280 + head * 64);
  }
  __syncthreads();
}
template <bool SWA>
DI void stage_wave_kv(char* kimg, char* vimg, const float* ksrc, const float* vsrc, int key0, int nvalid, const bf16* extra, int nextra, int head,
                      float* kcopy, float* vcopy, int lane) {
  f32x4 ka[8], kb[8], va[8], vb[8];
#pragma unroll
  for (int i = 0; i < 8; ++i) {
    const int id = lane + 64 * i, key = id >> 3, kc = id & 7, kk = key0 + key;
    ka[i] = kb[i] = va[i] = vb[i] = (f32x4){0.f, 0.f, 0.f, 0.f};
    if (kk < nvalid) {
      const size_t o = (size_t)kk * 256 + head * 64 + kc * 8;
      ka[i] = *(const f32x4*)(ksrc + o); kb[i] = *(const f32x4*)(ksrc + o + 4);
      va[i] = *(const f32x4*)(vsrc + o); vb[i] = *(const f32x4*)(vsrc + o + 4);
    } else if (SWA && kk - nvalid < nextra) {
      const bf16* e = extra + (size_t)(kk - nvalid) * 2560 + head * 64 + kc * 8;
      ka[i] = __builtin_bit_cast(f32x4, *(const u32x4*)e); va[i] = __builtin_bit_cast(f32x4, *(const u32x4*)(e + 256));
    }
  }
#pragma unroll
  for (int i = 0; i < 8; ++i) {
    const int id = lane + 64 * i, key = id >> 3, kc = id & 7, kk = key0 + key;
    u32x4 tk = __builtin_bit_cast(u32x4, ka[i]), tv = __builtin_bit_cast(u32x4, va[i]);
    if (kk < nvalid) {
      if (SWA && kk >= 8) {
        const size_t o = (size_t)(kk - 8) * 256 + head * 64 + kc * 8;
        *(f32x4*)(kcopy + o) = ka[i]; *(f32x4*)(kcopy + o + 4) = kb[i];
        *(f32x4*)(vcopy + o) = va[i]; *(f32x4*)(vcopy + o + 4) = vb[i];
      }
      tk = (u32x4){pack2(ka[i][0], ka[i][1]), pack2(ka[i][2], ka[i][3]), pack2(kb[i][0], kb[i][1]), pack2(kb[i][2], kb[i][3])};
      tv = (u32x4){pack2(va[i][0], va[i][1]), pack2(va[i][2], va[i][3]), pack2(vb[i][0], vb[i][1]), pack2(vb[i][2], vb[i][3])};
    }
    *(u32x4*)(kimg + key * 128 + ((kc ^ ((key >> 1) & 7)) << 4)) = tk;
    *(u32x4*)(vimg + key * 128 + ((kc ^ (((key >> 1) & 1) << 2)) << 4)) = tv;
  }
}
template <bool SWA>
DI void decode_unit(const Params& p, int layer, int unit, char* smem) {
  const int tid = threadIdx.x, lane = tid & 63, w = tid >> 6, r = lane & 31, h = lane >> 5;
  const int b = unit >> 1, hd = (unit & 1) * 2 + (w >> 2), c = w & 3;
  const int ldz = (SWA || layer) ? 2560 : 2048;
  char* kimg = smem + w * 16384; char* vimg = kimg + 8192;
  const int t = r & 7, g = SWA ? ((r >> 3) > 2 ? 2 : (r >> 3)) : 0;
  const int qhead = SWA ? hd * 3 + g : hd;
  const int qcol = SWA ? 512 : (layer ? 2048 : 1536);
  const int tok = NPR + b * 8 + t;
  bf16x8 qf[4];
  load_q(qf, p.z + (size_t)tok * ldz + qcol + qhead * 64, h);
  const bool active = SWA ? (c < 3) : true;
  if (active) {
    if (SWA) {
      const bf16* knew = p.z + (size_t)(NPR + b * 8) * 2560;
      stage_wave_kv<true>(kimg, vimg, p.cswk + (size_t)b * 32768, p.cswv + (size_t)b * 32768, c * 64, 128, knew, 8, hd,
                          p.out + O_SKS + (size_t)b * 32768, p.out + O_SVS + (size_t)b * 32768, lane);
    } else {
      stage_wave_kv<false>(kimg, vimg, p.cmk + ((size_t)layer * 128 + b) * 65536, p.cmv + ((size_t)layer * 128 + b) * 65536, c * 64, 256, nullptr, 0, hd,
                           nullptr, nullptr, lane);
    }
  }
  __syncthreads();
  float m = -1e30f, l = 0.f;
  if (SWA && c == 0) { m = p.sinks[qhead] * LOG2E; l = h == 0 ? 1.f : 0.f; }
  f32x16 o[2];
#pragma unroll
  for (int dt = 0; dt < 2; ++dt)
#pragma unroll
    for (int i = 0; i < 16; ++i) o[dt][i] = 0.f;
  if (active) attn_chunk<SWA>(qf, kimg, vimg, m, l, o, lane, SWA ? t + 1 - 64 * c : 0, SWA ? t + 128 - 64 * c : 63);
  __syncthreads();
  float* R = (float*)(smem + w * 16384);
  const float lt = l + __shfl_xor(l, 32);
#pragma unroll
  for (int dt = 0; dt < 2; ++dt)
#pragma unroll
    for (int i = 0; i < 16; ++i) R[(dt * 32 + crow(i, h)) * 32 + r] = o[dt][i];
  if (h == 0) { R[2048 + r] = m; R[2080 + r] = lt; }
  __syncthreads();
  const int head2 = tid >> 8, slot = (tid & 255) >> 3, dg = tid & 7;
  if (slot < (SWA ? 24 : 8)) {
    float mc[4], lc[4], M = -1e30f;
#pragma unroll
    for (int cc = 0; cc < 4; ++cc) {
      const float* Rc = (const float*)(smem + (head2 * 4 + cc) * 16384);
      mc[cc] = Rc[2048 + slot]; lc[cc] = Rc[2080 + slot];
      M = fmaxf(M, mc[cc]);
    }
    float L = 0.f, a8[8];
#pragma unroll
    for (int e = 0; e < 8; ++e) a8[e] = 0.f;
#pragma unroll
    for (int cc = 0; cc < 4; ++cc) {
      const float* Rc = (const float*)(smem + (head2 * 4 + cc) * 16384);
      const float wgt = __builtin_amdgcn_exp2f(mc[cc] - M);
      L += wgt * lc[cc];
#pragma unroll
      for (int e = 0; e < 8; ++e) a8[e] += wgt * Rc[(dg * 8 + e) * 32 + slot];
    }
    const float inv = 1.f / L;
    const int hd2 = (unit & 1) * 2 + head2, t2 = slot & 7, g2 = slot >> 3;
    const int tok2 = NPR + b * 8 + t2;
    const int ocol = SWA ? (hd2 * 3 + g2) * 64 : 768 + hd2 * 64;
    const int gcol = SWA ? 1280 + (hd2 * 3 + g2) * 64 : (layer ? 2304 : 1792) + hd2 * 64;
    const u32x4 gg = *(const u32x4*)(p.z + (size_t)tok2 * ldz + gcol + dg * 8);
    u32x4 ov;
#pragma unroll
    for (int e = 0; e < 4; ++e) ov[e] = pack2(a8[2 * e] * inv * bflo(gg[e]), a8[2 * e + 1] * inv * bfhi(gg[e]));
    *(u32x4*)(p.act + (size_t)tok2 * 1024 + ocol + dg * 8) = ov;
  }
  __syncthreads();
}
template <int W>
DI void pool_d_item(const Params& p, int tok, int c0, bf16* __restrict__ dbuf) {
  const bf16* __restrict__ zz = p.z;
  float a[8];
#pragma unroll
  for (int j = 0; j < 8; ++j) a[j] = 0.f;
  u32x4 u0 = {0u, 0u, 0u, 0u};
  float cnt;
  if (tok < NPR) {
    const int nr = tok + 1 < W ? tok + 1 : W;
    cnt = (float)nr;
    u32x4 t[W];
#pragma unroll
    for (int j = 0; j < W; ++j) { const int rr = tok - j < 0 ? 0 : tok - j; t[j] = *(const u32x4*)(zz + (size_t)rr * 2048 + c0); }
    u0 = t[0];
#pragma unroll
    for (int j = 0; j < W; ++j) {
      const float vm = j < nr ? 1.f : 0.f;
#pragma unroll
      for (int e = 0; e < 4; ++e) { a[2 * e] += vm * bflo(t[j][e]); a[2 * e + 1] += vm * bfhi(t[j][e]); }
    }
  } else {
    const int s = tok - NPR, b = s >> 3, t8 = s & 7;
    cnt = (float)W;
    u0 = *(const u32x4*)(zz + (size_t)tok * 2048 + c0);
#pragma unroll
    for (int j = 0; j < W; ++j) {
      const int tt = t8 - j;
      if (tt >= 0) {
        const u32x4 t = *(const u32x4*)(zz + (size_t)(tok - j) * 2048 + c0);
#pragma unroll
        for (int e = 0; e < 4; ++e) { a[2 * e] += bflo(t[e]); a[2 * e + 1] += bfhi(t[e]); }
      } else {
        const float* sp = p.state_pool + (size_t)(b * 15 + 15 + tt) * 768 + c0;
        const f32x4 x0 = *(const f32x4*)sp, x1 = *(const f32x4*)(sp + 4);
        a[0] += x0[0]; a[1] += x0[1]; a[2] += x0[2]; a[3] += x0[3]; a[4] += x1[0]; a[5] += x1[1]; a[6] += x1[2]; a[7] += x1[3];
      }
    }
  }
  const float ic = 1.f / cnt;
  u32x4 o;
#pragma unroll
  for (int e = 0; e < 4; ++e) o[e] = pack2(a[2 * e] * ic - bflo(u0[e]), a[2 * e + 1] * ic - bfhi(u0[e]));
  *(u32x4*)(dbuf + (size_t)tok * 768 + c0) = o;
}

DI void transpose_tile(const float* src, int K, int N, const float* gain, bf16* dst, int tile, char* smem, bool valid) {
  const int tid = threadIdx.x & 255;
  float* T = (float*)(smem + (threadIdx.x >> 8) * 16640);
  const int ntn = N >> 6, k0 = (tile / ntn) << 6, n0 = (tile % ntn) << 6;
  const int c4 = tid & 15, ri = tid >> 4;
  if (valid) {
#pragma unroll
    for (int i = 0; i < 4; ++i) {
      const int k = ri + 16 * i;
      f32x4 t = *(const f32x4*)(src + (size_t)(k0 + k) * N + n0 + c4 * 4);
      const float gsc = gain ? gain[k0 + k] : 1.f;
      T[k * 65 + c4 * 4] = t[0] * gsc; T[k * 65 + c4 * 4 + 1] = t[1] * gsc; T[k * 65 + c4 * 4 + 2] = t[2] * gsc; T[k * 65 + c4 * 4 + 3] = t[3] * gsc;
    }
  }
  __syncthreads();
  const int k8 = tid & 7, nn = tid >> 3;
  if (valid) {
#pragma unroll
    for (int i = 0; i < 2; ++i) {
      const int n = nn + 32 * i;
      const float* tp = T + (k8 * 8) * 65 + n;
      u32x4 o = {pack2(tp[0], tp[65]), pack2(tp[130], tp[195]), pack2(tp[260], tp[325]), pack2(tp[390], tp[455])};
      *(u32x4*)(dst + (size_t)(n0 + n) * K + k0 + k8 * 8) = o;
    }
  }
  __syncthreads();
}
DI void row_prep(const float* src, bf16* dst, float* rstd, int lane) {
  float ss = 0.f;
  f32x4 t[4];
#pragma unroll
  for (int i = 0; i < 4; ++i) { t[i] = *(const f32x4*)(src + i * 256 + lane * 4); ss += t[i][0] * t[i][0] + t[i][1] * t[i][1] + t[i][2] * t[i][2] + t[i][3] * t[i][3]; }
#pragma unroll
  for (int o = 32; o > 0; o >>= 1) ss += __shfl_xor(ss, o);
#pragma unroll
  for (int i = 0; i < 4; ++i) { u32x2 ov = {pack2(t[i][0], t[i][1]), pack2(t[i][2], t[i][3])}; *(u32x2*)(dst + i * 256 + lane * 4) = ov; }
  if (lane == 0) *rstd = rsqrtf(ss * (1.f / 1024.f) + EPS);
}

#define XB_TMO      128
#define XB_XCNT(j)  (256  + 64 * (j))
#define XB_XSUB(j)  (1280 + 64 * (j))
#define XB_XGEN(j)  (2304 + 64 * (j))
#define XB_TOP      3328
#define XB_TOPGEN   3392
#define XCD_BAR_WORDS 3456
#define XB_SPIN_CAP (1u << 18)
#define LAS __attribute__((address_space(3)))
DI unsigned xb_ld(unsigned* p) { return __hip_atomic_load(p, __ATOMIC_RELAXED, __HIP_MEMORY_SCOPE_AGENT); }
DI unsigned xb_add(unsigned* p, unsigned v) { return __hip_atomic_fetch_add(p, v, __ATOMIC_RELAXED, __HIP_MEMORY_SCOPE_AGENT); }
DI unsigned xb_xcc_id() { return (unsigned)__builtin_amdgcn_s_getreg((3 << 11) | 20) & 0xFu; }
#define XB_SPIN(cond, bar) do { unsigned _sp = 0; while (cond) { __builtin_amdgcn_s_sleep(1); \
    if ((++_sp & 255u) == 0u) { if (xb_ld(&(bar)[XB_TMO])) break; if (_sp > XB_SPIN_CAP) { atomicAdd(&(bar)[XB_TMO], 1u); break; } } } } while (0)
struct XcdBarrier { unsigned* bar; unsigned x; volatile LAS unsigned* st; };
DI XcdBarrier xcd_barrier_post(unsigned* bar, volatile LAS unsigned* st) {
  XcdBarrier b; b.bar = bar; b.x = xb_xcc_id(); b.st = st;
  if (threadIdx.x == 0) st[2] = xb_add(&bar[XB_XCNT(b.x)], 1u);
  return b;
}
DI void xcd_barrier_complete(unsigned* bar, unsigned x, unsigned& nloc, unsigned& nx) {
  const unsigned G = gridDim.x * gridDim.y * gridDim.z;
  unsigned sum, cnt, mine, sp = 0u;
  for (;;) {
    sum = 0u; cnt = 0u; mine = 0u;
#pragma unroll
    for (unsigned j = 0; j < 16; ++j) { const unsigned c = xb_ld(&bar[XB_XCNT(j)]); sum += c; cnt += (c > 0u) ? 1u : 0u; mine = (j == x) ? c : mine; }
    if (sum == G) break;
    __builtin_amdgcn_s_sleep(1);
    if ((++sp & 255u) == 0u) { if (xb_ld(&bar[XB_TMO])) break; if (sp > XB_SPIN_CAP) { atomicAdd(&bar[XB_TMO], 1u); break; } }
  }
  nloc = mine > 0u ? mine : 1u; nx = cnt > 0u ? cnt : 1u;
}
DI void xcd_barrier(const XcdBarrier& b) {
  asm volatile("s_waitcnt vmcnt(0)" ::: "memory");
  __syncthreads();
  if (threadIdx.x == 0) {
    unsigned* bar = b.bar;
    __builtin_amdgcn_s_waitcnt(0);
    unsigned nloc = b.st[0], nx = b.st[1];
    if (nloc == 0u) { xcd_barrier_complete(bar, b.x, nloc, nx); b.st[0] = nloc; b.st[1] = nx; }
    const unsigned old = xb_add(&bar[XB_XSUB(b.x)], 1u);
    const unsigned gen = old / nloc;
    if (old + 1u == (gen + 1u) * nloc) {
      __builtin_amdgcn_fence(__ATOMIC_RELEASE, "agent");
      asm volatile("s_waitcnt vmcnt(0)" ::: "memory");
      const unsigned og = xb_add(&bar[XB_TOP], 1u);
      const unsigned tg = og / nx;
      if (og + 1u == (tg + 1u) * nx) xb_add(&bar[XB_TOPGEN], 1u);
      else XB_SPIN(xb_ld(&bar[XB_TOPGEN]) == tg, bar);
      __builtin_amdgcn_fence(__ATOMIC_ACQUIRE, "agent");
      xb_add(&bar[XB_XGEN(b.x)], 1u);
      asm volatile("s_waitcnt vmcnt(0)" ::: "memory");
    } else {
      XB_SPIN(xb_ld(&bar[XB_XGEN(b.x)]) == gen, bar);
      __builtin_amdgcn_fence(__ATOMIC_ACQUIRE, "agent");
      asm volatile("s_waitcnt vmcnt(0)" ::: "memory");
    }
  }
  __syncthreads();
}

template <int PH>
DI void run_phase(const Params& p, char* smem, int vbid) {
  const int bid = blockIdx.x, nb = gridDim.x, tid = threadIdx.x, NT = 512;
  if constexpr (PH == 0) {
    {
      const int lane = tid & 63, w = tid >> 6;
#pragma unroll 1
      for (int u = bid; u < (NTOK + 256) / 16; u += nb) {
        const int row0 = u * 16 + w * 2;
        f32x4 t[2][4];
        const float* src[2]; bf16* dst[2]; float* rs[2];
#pragma unroll
        for (int q = 0; q < 2; ++q) {
          const int row = row0 + q;
          if (row < NTOK) { src[q] = xrow(p, row); dst[q] = p.xb + (size_t)row * 1024; rs[q] = p.rstd_a + row; }
          else { src[q] = p.memp + (size_t)(row - NTOK) * 1024; dst[q] = p.memb + (size_t)(row - NTOK) * 1024; rs[q] = p.rstd_mem + (row - NTOK); }
#pragma unroll
          for (int i = 0; i < 4; ++i) t[q][i] = *(const f32x4*)(src[q] + i * 256 + lane * 4);
        }
#pragma unroll
        for (int q = 0; q < 2; ++q) {
          float ss = 0.f;
#pragma unroll
          for (int i = 0; i < 4; ++i) ss += t[q][i][0] * t[q][i][0] + t[q][i][1] * t[q][i][1] + t[q][i][2] * t[q][i][2] + t[q][i][3] * t[q][i][3];
#pragma unroll
          for (int o = 32; o > 0; o >>= 1) ss += __shfl_xor(ss, o);
#pragma unroll
          for (int i = 0; i < 4; ++i) { u32x2 ov = {pack2(t[q][i][0], t[q][i][1]), pack2(t[q][i][2], t[q][i][3])}; *(u32x2*)(dst[q] + i * 256 + lane * 4) = ov; }
          if (lane == 0) *rs[q] = rsqrtf(ss * (1.f / 1024.f) + EPS);
        }
      }
    }
#pragma unroll 1
    for (int u = bid; u < 978; u += nb) {
      int t = u * 2 + (tid >> 8);
      const float* src; const float* gain = nullptr; bf16* dst; int K = 1024, N = 1024;
      if (t < 512) { src = p.w_in_a; N = 2048; gain = p.norm_a; dst = p.Wt_in_a; }
      else if ((t -= 512) < 256) { src = p.w_out_a; dst = p.Wt_out_a; }
      else if ((t -= 256) < 128) { src = p.w_kv; N = 512; gain = p.kv_norm; dst = p.Wt_kvb; }
      else if ((t -= 128) < 512) { src = p.w_in_b; N = 2048; gain = p.norm_b; dst = p.Wt_kvb + 512 * 1024; }
      else if ((t -= 512) < 256) { src = p.w_out_b; dst = p.Wt_out_b; }
      else if ((t -= 256) < 256) { const int l = t >> 7; t &= 127; src = p.w_mem_kv + (size_t)l * 1024 * 512; N = 512; gain = p.mem_norm + l * 1024; dst = p.Wt_mem + (size_t)l * 512 * 1024; }
      else { t -= 256; const int g = t / 9; t %= 9; src = p.pool_mix_w + (size_t)g * 192 * 192; K = 192; N = 192; dst = p.Wt_pool + (size_t)g * 192 * 768 + g * 192; }
      if (K == 192) {
        const int ltid = tid & 255;
        float* T = (float*)(smem + (tid >> 8) * 16640);
        const int k0 = (t / 3) << 6, n0 = (t % 3) << 6, c4 = ltid & 15, ri = ltid >> 4;
#pragma unroll
        for (int i = 0; i < 4; ++i) {
          const int k = ri + 16 * i;
          f32x4 x = *(const f32x4*)(src + (size_t)(k0 + k) * 192 + n0 + c4 * 4);
          T[k * 65 + c4 * 4] = x[0]; T[k * 65 + c4 * 4 + 1] = x[1]; T[k * 65 + c4 * 4 + 2] = x[2]; T[k * 65 + c4 * 4 + 3] = x[3];
        }
      }
      if (K != 192) transpose_tile(src, K, N, gain, dst, t, smem, true);
      else {
        __syncthreads();
        const int ltid = tid & 255, k8 = ltid & 7, nn = ltid >> 3;
        const float* T = (const float*)(smem + (tid >> 8) * 16640);
        const int k0 = (t / 3) << 6, n0 = (t % 3) << 6;
#pragma unroll
        for (int i = 0; i < 2; ++i) {
          const int n = nn + 32 * i;
          const float* tp = T + (k8 * 8) * 65 + n;
          u32x4 o = {pack2(tp[0], tp[65]), pack2(tp[130], tp[195]), pack2(tp[260], tp[325]), pack2(tp[390], tp[455])};
          *(u32x4*)(dst + (size_t)(n0 + n) * 768 + k0 + k8 * 8) = o;
        }
        __syncthreads();
      }
    }
    for (int i = bid * NT + tid; i < 768 * 96; i += nb * NT) {
      const int n = i / 96, k8 = i % 96;
      if (n / 192 != k8 / 24) { u32x4 zz = {0u, 0u, 0u, 0u}; *(u32x4*)(p.Wt_pool + (size_t)n * 768 + k8 * 8) = zz; }
    }
    for (int i = bid * NT + tid; i < NTOK; i += nb * NT) p.ssq1[i] = 0.f;
    for (int i = bid * NT + tid; i < 128 * 7 * 192; i += nb * NT) {
      const int b = i / (7 * 192), rem = i % (7 * 192);
      *(f32x4*)(p.out + O_POOLS + (size_t)b * 15 * 768 + rem * 4) = *(const f32x4*)(p.state_pool + (size_t)b * 15 * 768 + 8 * 768 + rem * 4);
    }
  } else if constexpr (PH == 1) {
    gemm_phase(p.xb, 1024, p.Wt_in_a, 1024, 16, 68, 8, smem, EpiInA{p}, vbid);
#pragma unroll 1
    for (int v = nb - 1 - ((nb & 255) == 0 ? ((vbid & 31) * (nb >> 5) + (vbid >> 5)) : vbid); v < 16; v += nb) gemm_tile<128, 128>(p.memb, 1024, p.Wt_mem, 1024, 16, (v >> 3) * 128, (v & 7) * 128, smem, EpiMemKV{p});
  } else if constexpr (PH == 2) {
#pragma unroll 1
    for (int u = bid; u < 256; u += nb) mem_attn_prompt(p, 0, u, smem);
    {
      bf16* dbuf = p.dbuf;
      const int lane = tid & 63, gw = bid * 8 + (tid >> 6), nw = nb * 8;
#pragma unroll 1
      for (int it = gw; it < (NTOK / 8) * 4; it += nw) {
        const int tg = it >> 2, g = it & 3;
        const int tok = tg * 8 + (lane >> 3), c0 = g * 192 + (lane & 7) * 8;
        if (g == 0) { pool_d_item<2>(p, tok, c0, dbuf); pool_d_item<2>(p, tok, c0 + 64, dbuf); pool_d_item<2>(p, tok, c0 + 128, dbuf); }
        else if (g == 1) { pool_d_item<4>(p, tok, c0, dbuf); pool_d_item<4>(p, tok, c0 + 64, dbuf); pool_d_item<4>(p, tok, c0 + 128, dbuf); }
        else if (g == 2) { pool_d_item<8>(p, tok, c0, dbuf); pool_d_item<8>(p, tok, c0 + 64, dbuf); pool_d_item<8>(p, tok, c0 + 128, dbuf); }
        else { pool_d_item<16>(p, tok, c0, dbuf); pool_d_item<16>(p, tok, c0 + 64, dbuf); pool_d_item<16>(p, tok, c0 + 128, dbuf); }
      }
    }
  } else if constexpr (PH == 3) {
    const int NG = 68 * 3, vb = (nb & 255) == 0 ? ((vbid & 31) * (nb >> 5) + (vbid >> 5)) : vbid;
    if (nb >= NG + 32) {
      if (vb < NG) {
        const int mt = vb / 3, nt = vb % 3;
        gemm_tile<256, 256>(p.dbuf + nt * 192, 768, p.Wt_pool + nt * 192, 768, 6, mt * 256, nt * 256, smem, EpiPool{p});
      } else {
#pragma unroll 1
        for (int u = vb - NG; u < 256; u += nb - NG) decode_unit<false>(p, 0, u, smem);
      }
    } else {
#pragma unroll 1
      for (int u = vb; u < NG; u += nb) {
        const int mt = u / 3, nt = u % 3;
        gemm_tile<256, 256>(p.dbuf + nt * 192, 768, p.Wt_pool + nt * 192, 768, 6, mt * 256, nt * 256, smem, EpiPool{p});
      }
#pragma unroll 1
      for (int u = bid; u < 256; u += nb) decode_unit<false>(p, 0, u, smem);
    }
  } else if constexpr (PH == 4) {
    gemm_phase(p.act, 1024, p.Wt_out_a, 1024, 16, 68, 4, smem, EpiOutA{p}, vbid);
  } else if constexpr (PH == 5) {
    gemm_phase(p.xb, 1024, p.Wt_kvb, 1024, 16, 68, 10, smem, EpiKVB{p}, vbid);
  } else if constexpr (PH == 6) {
#pragma unroll 1
    for (int u = bid; u < 256; u += nb) swa_prompt(p, u, smem);
#pragma unroll 1
    for (int u = bid; u < 256; u += nb) mem_attn_prompt(p, 1, u, smem);
#pragma unroll 1
    for (int u = bid; u < 256; u += nb) decode_unit<true>(p, 1, u, smem);
#pragma unroll 1
    for (int u = bid; u < 256; u += nb) decode_unit<false>(p, 1, u, smem);
  } else if constexpr (PH == 7) {
    gemm_phase(p.act, 1024, p.Wt_out_b, 1024, 16, 68, 4, smem, EpiOutB{p}, vbid);
  }
}

#if MULTI_LAUNCH
template <int PH>
__global__ void __launch_bounds__(512) phase_kernel(Params p) {
  __shared__ __attribute__((aligned(1024))) char smem[135168];
  run_phase<PH>(p, smem, blockIdx.x);
}
#else
__global__ void __launch_bounds__(512) yoco_megakernel(Params p) {
  __shared__ __attribute__((aligned(1024))) char smem[135168];
  __shared__ uint4 xb_words;
  if (threadIdx.x == 0) xb_words = make_uint4(0u, 0u, 0u, 0u);
  __syncthreads();
  XcdBarrier xb = xcd_barrier_post(p.bar, (volatile LAS unsigned*)&xb_words);
  run_phase<0>(p, smem, blockIdx.x); xcd_barrier(xb);
  if (threadIdx.x == 0) {
    const unsigned per = gridDim.x >> 3;
    bool even = (gridDim.x & 7u) == 0u;
    for (unsigned j = 0; j < 16; ++j) { const unsigned c = xb_ld(&p.bar[XB_XCNT(j)]); even = even && (j < 8 ? c == per : c == 0u); }
    const unsigned rank = ((volatile LAS unsigned*)&xb_words)[2];
    ((volatile LAS unsigned*)&xb_words)[3] = even ? xb.x * per + rank : blockIdx.x;
  }
  __syncthreads();
  const int vbid = (int)((volatile LAS unsigned*)&xb_words)[3];
  run_phase<1>(p, smem, vbid); xcd_barrier(xb);
  run_phase<2>(p, smem, vbid); xcd_barrier(xb);
  run_phase<3>(p, smem, vbid); xcd_barrier(xb);
  run_phase<4>(p, smem, vbid); xcd_barrier(xb);
  run_phase<5>(p, smem, vbid); xcd_barrier(xb);
  run_phase<6>(p, smem, vbid); xcd_barrier(xb);
  run_phase<7>(p, smem, vbid);
}
#endif

extern "C" void kernel_launch(void* const* d_in, const int* in_sizes, int n_in, void* d_out, int out_size, void* d_ws, size_t ws_size, hipStream_t stream) {
  Params p{};
  const float* const* in = (const float* const*)d_in;
  p.xp = in[0]; p.xs = in[1]; p.state_pool = in[2]; p.cswk = in[3]; p.cswv = in[4]; p.cmk = in[5]; p.cmv = in[6]; p.memp = in[7];
  p.norm_a = in[8]; p.w_in_a = in[9]; p.pool_mix_w = in[10]; p.pool_scale = in[11]; p.w_out_a = in[12]; p.kv_norm = in[13]; p.w_kv = in[14];
  p.k_norm = in[15]; p.norm_b = in[16]; p.w_in_b = in[17]; p.q_norm = in[18]; p.sinks = in[19]; p.w_out_b = in[20]; p.mem_norm = in[21];
  p.w_mem_kv = in[22]; p.mem_q_norm = in[23]; p.mem_k_norm = in[24];
  p.out = (float*)d_out;
  char* ws = (char*)d_ws;
  size_t off = 0;
  auto take = [&](size_t bytes) { char* r = ws + off; off += (bytes + 255) & ~(size_t)255; return r; };
  p.Wt_in_a = (bf16*)take((size_t)2048 * 1024 * 2);
  p.Wt_out_a = (bf16*)take((size_t)1024 * 1024 * 2);
  p.Wt_kvb = (bf16*)take((size_t)2560 * 1024 * 2);
  p.Wt_out_b = (bf16*)take((size_t)1024 * 1024 * 2);
  p.Wt_mem = (bf16*)take((size_t)1024 * 1024 * 2);
  p.Wt_pool = (bf16*)take((size_t)768 * 768 * 2);
  p.memb = (bf16*)take((size_t)256 * 1024 * 2);
  p.mkb = (bf16*)take((size_t)4 * 256 * 256 * 2);
  p.rstd_a = (float*)take((size_t)NTOK * 4);
  p.rstd_mem = (float*)take(256 * 4);
  p.ssq1 = (float*)take((size_t)NTOK * 4);
  p.bar = (unsigned*)take((size_t)XCD_BAR_WORDS * 4);
  p.xb = (bf16*)take((size_t)NTOK * 1024 * 2);
  p.act = (bf16*)take((size_t)NTOK * 1024 * 2);
  p.dbuf = (bf16*)take((size_t)NTOK * 768 * 2);
  p.z = (bf16*)take((size_t)NTOK * 2560 * 2);
  for (int i = 0; i < 8; ++i) p.rope_inv[i] = powf(500000.0f, -(float)i / 8.0f);
#if MULTI_LAUNCH
  const int grid = 256;
  phase_kernel<0><<<grid, 512, 0, stream>>>(p);
  phase_kernel<1><<<grid, 512, 0, stream>>>(p);
  phase_kernel<2><<<grid, 512, 0, stream>>>(p);
  phase_kernel<3><<<grid, 512, 0, stream>>>(p);
  phase_kernel<4><<<grid, 512, 0, stream>>>(p);
  phase_kernel<5><<<grid, 512, 0, stream>>>(p);
  phase_kernel<6><<<grid, 512, 0, stream>>>(p);
  phase_kernel<7><<<grid, 512, 0, stream>>>(p);
#else
  static int grid_blocks = 0;
  if (!grid_blocks) {
    int dev = 0, cus = 0, per_cu = 0;
    hipGetDevice(&dev);
    hipDeviceGetAttribute(&cus, hipDeviceAttributeMultiprocessorCount, dev);
    (void)hipOccupancyMaxActiveBlocksPerMultiprocessor(&per_cu, yoco_megakernel, 512, 0);
    if (per_cu > 1) per_cu = 1;
    grid_blocks = cus * per_cu;
  }
  (void)hipMemsetAsync(p.bar, 0, (size_t)XCD_BAR_WORDS * 4, stream);
  void* args[] = {&p};
  hipError_t e = hipLaunchCooperativeKernel((void*)yoco_megakernel, dim3(grid_blocks), dim3(512), args, 0, stream);
  if (e != hipSuccess) fprintf(stderr, "cooperative launch failed: %s (grid %d)\n", hipGetErrorString(e), grid_blocks);
#endif
}
```

```cpp
#include <hip/hip_runtime.h>
#include <hip/hip_cooperative_groups.h>
#include <cstdio>
#include <cmath>
namespace cg = cooperative_groups;

#ifndef MULTI_LAUNCH
#define MULTI_LAUNCH 0
#endif

typedef unsigned short bf16;
typedef short bf16x8 __attribute__((ext_vector_type(8)));
typedef short s16x4 __attribute__((ext_vector_type(4)));
typedef float f32x16 __attribute__((ext_vector_type(16)));
typedef float f32x4 __attribute__((ext_vector_type(4)));
typedef unsigned u32x4 __attribute__((ext_vector_type(4)));
typedef unsigned u32x2 __attribute__((ext_vector_type(2)));
#define DI __device__ __forceinline__
#define MFMA32(a, b, c) __builtin_amdgcn_mfma_f32_32x32x16_bf16((a), (b), (c), 0, 0, 0)

constexpr int NTOK = 17408, NPR = 16384, DM = 1024;
constexpr float EPS = 1e-6f;
constexpr float LOG2E = 1.4426950408889634f;
constexpr size_t O_Y = 0, O_POOLP = 17825792, O_POOLS = 17837312, O_SKP = 19311872, O_SVP = 19344640,
                 O_SKS = 19377408, O_SVS = 23571712, O_MKP = 27766016, O_MVP = 27897088;

struct Params {
  const float *xp, *xs, *state_pool, *cswk, *cswv, *cmk, *cmv, *memp;
  const float *norm_a, *w_in_a, *pool_mix_w, *pool_scale, *w_out_a, *kv_norm, *w_kv, *k_norm, *norm_b, *w_in_b, *q_norm,
      *sinks, *w_out_b, *mem_norm, *w_mem_kv, *mem_q_norm, *mem_k_norm;
  float* out;
  bf16 *Wt_in_a, *Wt_out_a, *Wt_kvb, *Wt_out_b, *Wt_mem, *Wt_pool;
  bf16 *xb, *act, *z, *memb, *mkb, *dbuf;
  float *rstd_a, *rstd_mem, *ssq1;
  unsigned* bar;
  float rope_inv[8];
};

DI unsigned pack2(float a, float b) {
  typedef __bf16 bf2 __attribute__((ext_vector_type(2)));
  typedef float f2 __attribute__((ext_vector_type(2)));
  f2 f = {a, b};
  return __builtin_bit_cast(unsigned, __builtin_convertvector(f, bf2));
}
DI float bflo(unsigned u) { return __uint_as_float(u << 16); }
DI float bfhi(unsigned u) { return __uint_as_float(u & 0xffff0000u); }
DI float silu(float x) { return x * __builtin_amdgcn_rcpf(1.f + __builtin_amdgcn_exp2f(-LOG2E * x)); }
DI int crow(int i, int h) { return (i & 3) + 8 * (i >> 2) + 4 * h; }
DI const float* xrow(const Params& p, int tok) { return tok < NPR ? p.xp + (size_t)tok * DM : p.xs + (size_t)(tok - NPR) * DM; }

template <int MI, int NI>
DI void frag_read(u32x4 (&fa)[MI], u32x4 (&fb)[NI], unsigned ab, unsigned bb) {
  if constexpr (MI == 4 && NI == 2) {
    asm volatile("ds_read_b128 %0, %6\n\tds_read_b128 %1, %6 offset:2048\n\tds_read_b128 %2, %6 offset:4096\n\tds_read_b128 %3, %6 offset:6144\n\t"
                 "ds_read_b128 %4, %7\n\tds_read_b128 %5, %7 offset:2048"
                 : "=&v"(fa[0]), "=&v"(fa[1]), "=&v"(fa[2]), "=&v"(fa[3]), "=&v"(fb[0]), "=&v"(fb[1]) : "v"(ab), "v"(bb) : "memory");
  } else {
    static_assert((MI == 4 && NI == 2) || (MI == 2 && NI == 1), "tile config");
    asm volatile("ds_read_b128 %0, %3\n\tds_read_b128 %1, %3 offset:2048\n\tds_read_b128 %2, %4"
                 : "=&v"(fa[0]), "=&v"(fa[1]), "=&v"(fb[0]) : "v"(ab), "v"(bb) : "memory");
  }
}
template <int KEEP, int MI, int NI>
DI void frag_wait(u32x4 (&fa)[MI], u32x4 (&fb)[NI]) {
  if constexpr (MI == 4 && NI == 2)
    asm volatile("s_waitcnt lgkmcnt(%6)" : "+v"(fa[0]), "+v"(fa[1]), "+v"(fa[2]), "+v"(fa[3]), "+v"(fb[0]), "+v"(fb[1]) : "n"(KEEP) : "memory");
  else
    asm volatile("s_waitcnt lgkmcnt(%3)" : "+v"(fa[0]), "+v"(fa[1]), "+v"(fb[0]) : "n"(KEEP) : "memory");
}
template <int BM, int BN, class Epi>
DI void gemm_tile(const bf16* __restrict__ A, int lda, const bf16* __restrict__ Bt, int ldb, int nk64, int m0, int n0, char* smem, const Epi& epi) {
  constexpr int RW = BM / 2, CW = BN / 4, MI = RW / 32, NI = CW / 32;
  constexpr int A_BYTES = BM * 64, B_BYTES = BN * 64, STAGE = A_BYTES + B_BYTES, GA = BM / 128, GB = BN / 128, GT = GA + GB;
  const int nk = nk64 * 2;
  const int tid = threadIdx.x, lane = tid & 63, w = tid >> 6;
  const int wm = w >> 2, wn = w & 3, r = lane & 31, h = lane >> 5;
  f32x16 acc[MI][NI];
#pragma unroll
  for (int mi = 0; mi < MI; ++mi)
#pragma unroll
    for (int ni = 0; ni < NI; ++ni)
#pragma unroll
      for (int i = 0; i < 16; ++i) acc[mi][ni][i] = 0.f;
  const int srow = w * 16 + (lane >> 2);
  const int slc = (lane & 3) ^ ((srow >> 2) & 3);
  const bf16* Ag = A + (size_t)(m0 + srow) * lda + slc * 8;
  const bf16* Bg = Bt + (size_t)(n0 + srow) * ldb + slc * 8;
#define GEMM_STAGE(buf, kt)                                                                                                        \
  do {                                                                                                                             \
    char* sa_ = smem + (buf) * STAGE + w * 1024;                                                                                   \
    _Pragma("unroll") for (int i = 0; i < GA; ++i)                                                                                 \
        __builtin_amdgcn_global_load_lds((const unsigned*)(Ag + (size_t)(128 * i) * lda + (kt) * 32), (unsigned*)(sa_ + i * 8192), 16, 0, 0); \
    _Pragma("unroll") for (int i = 0; i < GB; ++i)                                                                                 \
        __builtin_amdgcn_global_load_lds((const unsigned*)(Bg + (size_t)(128 * i) * ldb + (kt) * 32), (unsigned*)(sa_ + A_BYTES + i * 8192), 16, 0, 0); \
  } while (0)
#define WAIT_V(n) asm volatile("s_waitcnt vmcnt(%0)" ::"n"(n) : "memory")
  asm volatile("s_waitcnt vmcnt(0)" ::: "memory");
  GEMM_STAGE(0, 0);
  GEMM_STAGE(1, 1);
  GEMM_STAGE(2, 2);
  int aoff[MI], boff[NI];
#pragma unroll
  for (int mi = 0; mi < MI; ++mi) { const int row = wm * RW + mi * 32 + r; aoff[mi] = row * 64 + ((h ^ ((row >> 2) & 3)) << 4); }
#pragma unroll
  for (int ni = 0; ni < NI; ++ni) { const int row = wn * CW + ni * 32 + r; boff[ni] = A_BYTES + row * 64 + ((h ^ ((row >> 2) & 3)) << 4); }
  constexpr int RD = MI + NI;
  const unsigned sb0 = (unsigned)(size_t)smem;
  u32x4 fa0[MI], fb0[NI], fa1[MI], fb1[NI];
#define GEMM_MMA(FA, FB)                                                                                   \
  _Pragma("unroll") for (int mi = 0; mi < MI; ++mi) _Pragma("unroll") for (int ni = 0; ni < NI; ++ni)      \
      acc[mi][ni] = MFMA32(__builtin_bit_cast(bf16x8, FB[ni]), __builtin_bit_cast(bf16x8, FA[mi]), acc[mi][ni])
  WAIT_V(2 * GT);
  __builtin_amdgcn_s_barrier();
  asm volatile("" ::: "memory");
  frag_read<MI, NI>(fa0, fb0, sb0 + (unsigned)aoff[0], sb0 + (unsigned)boff[0]);
#pragma unroll 1
  for (int kt = 0; kt < nk - 1; ++kt) {
    if (kt + 2 < nk) WAIT_V(GT); else WAIT_V(0);
    __builtin_amdgcn_s_barrier();
    asm volatile("" ::: "memory");
    if (kt + 3 < nk) GEMM_STAGE((kt + 3) & 3, kt + 3);
    const unsigned sc = sb0 + (unsigned)((kt & 3) * STAGE), sn = sb0 + (unsigned)(((kt + 1) & 3) * STAGE);
    frag_read<MI, NI>(fa1, fb1, (sc + (unsigned)aoff[0]) ^ 32u, (sc + (unsigned)boff[0]) ^ 32u);
    frag_wait<RD, MI, NI>(fa0, fb0);
    GEMM_MMA(fa0, fb0);
    frag_read<MI, NI>(fa0, fb0, sn + (unsigned)aoff[0], sn + (unsigned)boff[0]);
    frag_wait<RD, MI, NI>(fa1, fb1);
    GEMM_MMA(fa1, fb1);
  }
  {
    const unsigned sc = sb0 + (unsigned)(((nk - 1) & 3) * STAGE);
    frag_read<MI, NI>(fa1, fb1, (sc + (unsigned)aoff[0]) ^ 32u, (sc + (unsigned)boff[0]) ^ 32u);
    frag_wait<RD, MI, NI>(fa0, fb0);
    GEMM_MMA(fa0, fb0);
    frag_wait<0, MI, NI>(fa1, fb1);
    GEMM_MMA(fa1, fb1);
  }
#undef GEMM_MMA
#undef GEMM_STAGE
#undef WAIT_V
  __syncthreads();
  constexpr int CPB = (BN + 8) * 2, SEGS = BN / 32, ITEMS = BM * SEGS / 512;
#pragma unroll
  for (int mi = 0; mi < MI; ++mi)
#pragma unroll
    for (int ni = 0; ni < NI; ++ni)
#pragma unroll
      for (int g = 0; g < 4; ++g) {
        const int row = wm * RW + mi * 32 + r, col = wn * CW + ni * 32 + 8 * g + 4 * h;
        u32x2 pk = {pack2(acc[mi][ni][4 * g], acc[mi][ni][4 * g + 1]), pack2(acc[mi][ni][4 * g + 2], acc[mi][ni][4 * g + 3])};
        *(u32x2*)(smem + row * CPB + col * 2) = pk;
      }
  __syncthreads();
  typename Epi::Pre pre[ITEMS];
#pragma unroll
  for (int it = 0; it < ITEMS; ++it) {
    const int item = it * 512 + tid, prow = item / SEGS, seg = item % SEGS;
    epi.prefetch(m0 + prow, n0 + seg * 32, pre[it]);
  }
#pragma unroll
  for (int it = 0; it < ITEMS; ++it) {
    const int item = it * 512 + tid, prow = item / SEGS, seg = item % SEGS;
    float v[32];
#pragma unroll
    for (int j = 0; j < 4; ++j) {
      const u32x4 t = *(const u32x4*)(smem + prow * CPB + seg * 64 + 16 * j);
#pragma unroll
      for (int e = 0; e < 4; ++e) { v[8 * j + 2 * e] = bflo(t[e]); v[8 * j + 2 * e + 1] = bfhi(t[e]); }
    }
    epi(m0 + prow, n0 + seg * 32, v, pre[it]);
    if constexpr (Epi::LDS_OUT) {
#pragma unroll
      for (int j = 0; j < 4; ++j) {
        u32x4 o = {pack2(v[8 * j], v[8 * j + 1]), pack2(v[8 * j + 2], v[8 * j + 3]), pack2(v[8 * j + 4], v[8 * j + 5]), pack2(v[8 * j + 6], v[8 * j + 7])};
        *(u32x4*)(smem + prow * CPB + seg * 64 + 16 * j) = o;
      }
    }
  }
  __syncthreads();
  if constexpr (Epi::LDS_OUT) {
    constexpr int CH = BN / 8, NIT = BM * CH / 512;
    bf16* ob = epi.out_base() + (size_t)m0 * epi.out_ld() + n0;
    const int ld = epi.out_ld();
#pragma unroll 4
    for (int it = 0; it < NIT; ++it) {
      const int idx = it * 512 + tid, row = idx / CH, c8 = idx % CH;
      const u32x4 t = *(const u32x4*)(smem + row * CPB + c8 * 16);
      *(u32x4*)(ob + (size_t)row * ld + c8 * 8) = t;
    }
    __syncthreads();
  }
}
template <class Epi>
DI void gemm_phase(const bf16* A, int lda, const bf16* Bt, int ldb, int nk, int MT, int NT, char* smem, const Epi& epi, int g_vb) {
  const int nb = gridDim.x;
  const int vb = g_vb;
  const int U = MT * NT, full = (U / nb) * nb, rem = U - full;
#pragma unroll 1
  for (int u = vb; u < full; u += nb) gemm_tile<256, 256>(A, lda, Bt, ldb, nk, (u / NT) * 256, (u % NT) * 256, smem, epi);
  if (rem * 4 <= nb) {
    const int tvb = (nb & 255) == 0 ? ((vb & 31) * (nb >> 5) + (vb >> 5)) : vb;
#pragma unroll 1
    for (int sidx = tvb; sidx < rem * 4; sidx += nb) {
      const int u = full + (sidx >> 2), q = sidx & 3;
      gemm_tile<128, 128>(A, lda, Bt, ldb, nk, (u / NT) * 256 + (q >> 1) * 128, (u % NT) * 256 + (q & 1) * 128, smem, epi);
    }
  } else {
#pragma unroll 1
    for (int u = full + vb; u < U; u += nb) gemm_tile<256, 256>(A, lda, Bt, ldb, nk, (u / NT) * 256, (u % NT) * 256, smem, epi);
  }
}

template <int NC>
DI void store_bf16(bf16* dst, const float (&v)[NC]) {
#pragma unroll
  for (int j = 0; j < NC / 8; ++j) {
    u32x4 o = {pack2(v[8 * j], v[8 * j + 1]), pack2(v[8 * j + 2], v[8 * j + 3]), pack2(v[8 * j + 4], v[8 * j + 5]), pack2(v[8 * j + 6], v[8 * j + 7])};
    *(u32x4*)(dst + 8 * j) = o;
  }
}
template <int NC>
DI void store_f32(float* dst, const float (&v)[NC]) {
#pragma unroll
  for (int j = 0; j < NC / 4; ++j) { f32x4 o = {v[4 * j], v[4 * j + 1], v[4 * j + 2], v[4 * j + 3]}; *(f32x4*)(dst + 4 * j) = o; }
}
DI void head_rmsnorm(float (&v)[32], const float* gain, int hoff, float post) {
  float ss = 0.f;
#pragma unroll
  for (int j = 0; j < 32; ++j) ss += v[j] * v[j];
  ss += __shfl_xor(ss, 1);
  const float rs = rsqrtf(ss * (1.f / 64.f) + EPS) * post;
#pragma unroll
  for (int j = 0; j < 32; ++j) v[j] = v[j] * rs * gain[hoff + j];
}
DI void rope16(float (&v)[32], int pos, const float* inv) {
#pragma unroll
  for (int i = 0; i < 8; ++i) {
    double rev = (double)pos * (double)inv[i] * 0.15915494309189535;
    rev -= floor(rev);
    const float fr = (float)rev;
    const float sn = __builtin_amdgcn_sinf(fr), cs = __builtin_amdgcn_cosf(fr);
    const float a = v[i], b = v[i + 8];
    v[i] = a * cs - b * sn;
    v[i + 8] = b * cs + a * sn;
  }
}

struct EpiInA {
  static constexpr bool LDS_OUT = true;
  DI bf16* out_base() const { return p.z; }
  DI int out_ld() const { return 2048; }
  const Params& p;
  struct Pre { float rs; };
  DI void prefetch(int row, int col, Pre& q) const { q.rs = p.rstd_a[row]; }
  DI void operator()(int row, int col, float (&v)[32], const Pre& q) const {
    const float rs = q.rs;
#pragma unroll
    for (int j = 0; j < 32; ++j) v[j] *= rs;
    if (col < 768) {
      if (row >= NPR - 15) {
        if (row < NPR) store_f32<32>(p.out + O_POOLP + (size_t)(row - (NPR - 15)) * 768 + col, v);
        else { const int s = row - NPR, b = s >> 3, t = s & 7; store_f32<32>(p.out + O_POOLS + (size_t)(b * 15 + 7 + t) * 768 + col, v); }
      }
    } else if (col < 1536) {
#pragma unroll
      for (int j = 0; j < 32; ++j) v[j] = silu(v[j]);
    } else if (col < 1792) {
      head_rmsnorm(v, p.mem_q_norm, col & 63, 0.125f * LOG2E);
    } else {
#pragma unroll
      for (int j = 0; j < 32; ++j) v[j] = silu(v[j]);
    }
  }
};
struct EpiMemKV {
  static constexpr bool LDS_OUT = false;
  DI bf16* out_base() const { return nullptr; }
  DI int out_ld() const { return 0; }
  const Params& p;
  struct Pre { float rs; };
  DI void prefetch(int row, int col, Pre& q) const { q.rs = p.rstd_mem[row]; }
  DI void operator()(int row, int col, float (&v)[32], const Pre& q) const {
    const float rs = q.rs;
#pragma unroll
    for (int j = 0; j < 32; ++j) v[j] *= rs;
    const int l = col >> 9, wi = col & 511;
    const bool isk = wi < 256;
    if (isk) head_rmsnorm(v, p.mem_k_norm + l * 64, col & 63, 1.f);
    const size_t e = (size_t)(l * 256 + row) * 256 + (wi & 255) + (isk ? 0 : 131072);
    store_f32<32>(p.out + O_MKP + e, v);
    store_bf16<32>(p.mkb + e, v);
  }
};
struct EpiPool {
  static constexpr bool LDS_OUT = false;
  DI bf16* out_base() const { return nullptr; }
  DI int out_ld() const { return 0; }
  const Params& p;
  struct Pre { u32x4 g[4]; };
  DI void prefetch(int row, int col, Pre& pq) const {
    const bf16* gp = p.z + (size_t)row * 2048 + 768 + col;
#pragma unroll
    for (int q = 0; q < 4; ++q) pq.g[q] = *(const u32x4*)(gp + 8 * q);
  }
  DI void operator()(int row, int col, float (&v)[32], const Pre& pq) const {
    const float* sc = p.pool_scale + col;
#pragma unroll
    for (int q = 0; q < 4; ++q) {
      const u32x4 g = pq.g[q];
#pragma unroll
      for (int j = 0; j < 4; ++j) { v[8 * q + 2 * j] *= sc[8 * q + 2 * j] * bflo(g[j]); v[8 * q + 2 * j + 1] *= sc[8 * q + 2 * j + 1] * bfhi(g[j]); }
    }
    store_bf16<32>(p.act + (size_t)row * 1024 + col, v);
  }
};
struct EpiOutA {
  static constexpr bool LDS_OUT = false;
  DI bf16* out_base() const { return nullptr; }
  DI int out_ld() const { return 0; }
  const Params& p;
  struct Pre { u32x4 x[4]; };
  DI void prefetch(int row, int col, Pre& q) const {
    const bf16* xr = p.xb + (size_t)row * 1024 + col;
#pragma unroll
    for (int j = 0; j < 4; ++j) q.x[j] = *(const u32x4*)(xr + 8 * j);
  }
  DI void operator()(int row, int col, float (&v)[32], const Pre& q) const {
    float ss = 0.f;
#pragma unroll
    for (int j = 0; j < 4; ++j)
#pragma unroll
      for (int e = 0; e < 4; ++e) { v[8 * j + 2 * e] += bflo(q.x[j][e]); v[8 * j + 2 * e + 1] += bfhi(q.x[j][e]); }
#pragma unroll
    for (int j = 0; j < 32; ++j) ss += v[j] * v[j];
    ss += __shfl_xor(ss, 1);
    ss += __shfl_xor(ss, 2);
    if ((threadIdx.x & 3) == 0) atomicAdd(p.ssq1 + row, ss);
    store_bf16<32>(p.xb + (size_t)row * 1024 + col, v);
  }
};
struct EpiKVB {
  static constexpr bool LDS_OUT = true;
  DI bf16* out_base() const { return p.z; }
  DI int out_ld() const { return 2560; }
  const Params& p;
  struct Pre { float ssq; };
  DI void prefetch(int row, int col, Pre& q) const { q.ssq = p.ssq1[row]; }
  DI void operator()(int row, int col, float (&v)[32], const Pre& q) const {
    const float rs = rsqrtf(q.ssq * (1.f / 1024.f) + EPS);
#pragma unroll
    for (int j = 0; j < 32; ++j) v[j] *= rs;
    const int pos = row < NPR ? row : NPR + ((row - NPR) & 7);
    if (col < 512) {
      if (col < 256) {
        head_rmsnorm(v, p.k_norm, col & 63, 1.f);
        if ((col & 63) == 0) rope16(v, pos, p.rope_inv);
      }
      const size_t ob = col < 256 ? 0 : (O_SVP - O_SKP);
      const size_t obs = col < 256 ? 0 : (O_SVS - O_SKS);
      const int c = col & 255;
      if (row >= NPR - 128) {
        if (row < NPR) store_f32<32>(p.out + O_SKP + ob + (size_t)(row - (NPR - 128)) * 256 + c, v);
        else { const int s = row - NPR, b = s >> 3, t = s & 7; store_f32<32>(p.out + O_SKS + obs + (size_t)(b * 128 + 120 + t) * 256 + c, v); }
      }
    } else if (col < 1280) {
      head_rmsnorm(v, p.q_norm, col & 63, 0.125f * LOG2E);
      if ((col & 63) == 0) rope16(v, pos, p.rope_inv);
    } else if (col < 2048) {
#pragma unroll
      for (int j = 0; j < 32; ++j) v[j] = silu(v[j]);
    } else if (col < 2304) {
      head_rmsnorm(v, p.mem_q_norm + 64, col & 63, 0.125f * LOG2E);
    } else {
#pragma unroll
      for (int j = 0; j < 32; ++j) v[j] = silu(v[j]);
    }
  }
};
struct EpiOutB {
  static constexpr bool LDS_OUT = false;
  DI bf16* out_base() const { return nullptr; }
  DI int out_ld() const { return 0; }
  const Params& p;
  struct Pre { u32x4 x[4]; };
  DI void prefetch(int row, int col, Pre& q) const {
    const bf16* xr = p.xb + (size_t)row * 1024 + col;
#pragma unroll
    for (int j = 0; j < 4; ++j) q.x[j] = *(const u32x4*)(xr + 8 * j);
  }
  DI void operator()(int row, int col, float (&v)[32], const Pre& q) const {
#pragma unroll
    for (int j = 0; j < 4; ++j)
#pragma unroll
      for (int e = 0; e < 4; ++e) { v[8 * j + 2 * e] += bflo(q.x[j][e]); v[8 * j + 2 * e + 1] += bfhi(q.x[j][e]); }
    store_f32<32>(p.out + O_Y + (size_t)row * 1024 + col, v);
  }
};

template <bool MASKED>
DI void attn_chunk(const bf16x8 (&qf)[4], const char* kimg, const char* vimg, float& m, float& l, f32x16 (&o)[2], int lane, int lo, int hi) {
  const int r = lane & 31, h = lane >> 5;
  f32x16 s[2];
#pragma unroll
  for (int kt = 0; kt < 2; ++kt) {
#pragma unroll
    for (int i = 0; i < 16; ++i) s[kt][i] = 0.f;
#pragma unroll
    for (int ks = 0; ks < 4; ++ks) {
      const int row = kt * 32 + r, chunk = ks * 2 + h;
      const bf16x8 kf = *(const bf16x8*)(kimg + row * 128 + ((chunk ^ ((row >> 1) & 7)) << 4));
      s[kt] = MFMA32(kf, qf[ks], s[kt]);
    }
  }
  float mx = -1e30f;
#pragma unroll
  for (int kt = 0; kt < 2; ++kt)
#pragma unroll
    for (int i = 0; i < 16; ++i) {
      if (MASKED) {
        const int kk = kt * 32 + crow(i, h);
        const bool ok = (kk >= lo) && (kk <= hi);
        s[kt][i] = ok ? s[kt][i] : -1e30f;
      }
      mx = fmaxf(mx, s[kt][i]);
    }
  mx = fmaxf(mx, __shfl_xor(mx, 32));
  const float mn = fmaxf(m, mx);
  const float alpha = __builtin_amdgcn_exp2f(m - mn);
  m = mn;
  float ps = 0.f;
#pragma unroll
  for (int kt = 0; kt < 2; ++kt)
#pragma unroll
    for (int i = 0; i < 16; ++i) {
      const float pv = (!MASKED || s[kt][i] > -1e29f) ? __builtin_amdgcn_exp2f(s[kt][i] - mn) : 0.f;
      s[kt][i] = pv;
      ps += pv;
    }
  l = l * alpha + ps;
#pragma unroll
  for (int dt = 0; dt < 2; ++dt)
#pragma unroll
    for (int i = 0; i < 16; ++i) o[dt][i] *= alpha;
  const int i16 = lane & 15, q = i16 >> 2, pp = i16 & 3, blk = (lane >> 4) & 1;
#pragma unroll
  for (int kt = 0; kt < 2; ++kt)
#pragma unroll
    for (int st = 0; st < 2; ++st) {
      u32x4 pk = {pack2(s[kt][8 * st], s[kt][8 * st + 1]), pack2(s[kt][8 * st + 2], s[kt][8 * st + 3]),
                  pack2(s[kt][8 * st + 4], s[kt][8 * st + 5]), pack2(s[kt][8 * st + 6], s[kt][8 * st + 7])};
      const bf16x8 pf = __builtin_bit_cast(bf16x8, pk);
      const int row = kt * 32 + st * 16 + 4 * h + q;
#pragma unroll
      for (int dt = 0; dt < 2; ++dt) {
        const int cb = (dt * 32 + blk * 16 + pp * 4) * 2;
        const int a0 = row * 128 + (cb ^ (((row >> 1) & 1) << 6));
        const s16x4 lo4 = __builtin_amdgcn_ds_read_tr16_b64_v4i16((s16x4 __attribute__((address_space(3)))*)(vimg + a0));
        const s16x4 hi4 = __builtin_amdgcn_ds_read_tr16_b64_v4i16((s16x4 __attribute__((address_space(3)))*)(vimg + a0 + 8 * 128));
        const bf16x8 vf = __builtin_shufflevector(lo4, hi4, 0, 1, 2, 3, 4, 5, 6, 7);
        o[dt] = MFMA32(vf, pf, o[dt]);
      }
    }
}
DI void attn_store(const f32x16 (&o)[2], float l, int lane, bool valid, bf16* dst, const bf16* gate) {
  const int h = lane >> 5;
  const float lt = l + __shfl_xor(l, 32);
  const float inv = 1.f / lt;
  if (valid) {
#pragma unroll
    for (int dt = 0; dt < 2; ++dt)
#pragma unroll
      for (int g4 = 0; g4 < 4; ++g4) {
        const int d0 = dt * 32 + g4 * 8 + 4 * h;
        const u32x2 gg = *(const u32x2*)(gate + d0);
        u32x2 ov = {pack2(o[dt][4 * g4] * inv * bflo(gg[0]), o[dt][4 * g4 + 1] * inv * bfhi(gg[0])),
                    pack2(o[dt][4 * g4 + 2] * inv * bflo(gg[1]), o[dt][4 * g4 + 3] * inv * bfhi(gg[1]))};
        *(u32x2*)(dst + d0) = ov;
      }
  }
}
DI void load_q(bf16x8 (&qf)[4], const bf16* qrow, int h) {
#pragma unroll
  for (int ks = 0; ks < 4; ++ks) qf[ks] = *(const bf16x8*)(qrow + ks * 16 + 8 * h);
}
template <int NROWS>
DI void stage_bf16(char* img, const bf16* src, int ld, bool vimg, int zero_below) {
  const int tid = threadIdx.x;
#pragma unroll
  for (int i = 0; i < NROWS / 64; ++i) {
    const int id = tid + 512 * i, row = id >> 3, kc = id & 7;
    u32x4 t = {0u, 0u, 0u, 0u};
    if (row >= zero_below) t = *(const u32x4*)(src + (ptrdiff_t)row * ld + kc * 8);
    const int sw = vimg ? (kc ^ (((row >> 1) & 1) << 2)) : (kc ^ ((row >> 1) & 7));
    *(u32x4*)(img + row * 128 + (sw << 4)) = t;
  }
}

DI void mem_attn_prompt(const Params& p, int layer, int unit, char* smem) {
  const int tt = unit >> 2, hh = unit & 3;
  const int lane = threadIdx.x & 63, w = threadIdx.x >> 6, r = lane & 31, h = lane >> 5;
  const int ldz = layer ? 2560 : 2048, qcol = layer ? 2048 : 1536, gcol = layer ? 2304 : 1792;
  char* kimg = smem; char* vimg = smem + 32768;
  stage_bf16<256>(kimg, p.mkb + (size_t)layer * 65536 + hh * 64, 256, false, 0);
  stage_bf16<256>(vimg, p.mkb + 131072 + (size_t)layer * 65536 + hh * 64, 256, true, 0);
  const int tok = tt * 256 + w * 32 + r;
  bf16x8 qf[4];
  load_q(qf, p.z + (size_t)tok * ldz + qcol + hh * 64, h);
  __syncthreads();
  float m = -1e30f, l = 0.f;
  f32x16 o[2];
#pragma unroll
  for (int dt = 0; dt < 2; ++dt)
#pragma unroll
    for (int i = 0; i < 16; ++i) o[dt][i] = 0.f;
#pragma unroll 1
  for (int c = 0; c < 4; ++c) attn_chunk<false>(qf, kimg + c * 8192, vimg + c * 8192, m, l, o, lane, 0, 63);
  attn_store(o, l, lane, true, p.act + (size_t)tok * 1024 + 768 + hh * 64, p.z + (size_t)tok * ldz + gcol + hh * 64);
  __syncthreads();
}
DI void swa_prompt(const Params& p, int unit, char* smem) {
  const int n = unit >> 2, kvh = unit & 3;
  const int lane = threadIdx.x & 63, w = threadIdx.x >> 6, r = lane & 31, h = lane >> 5;
  char* kimg = smem; char* vimg = smem + 49152;
  const bf16* kv0 = p.z + (ptrdiff_t)(n * 256 - 128) * 2560 + kvh * 64;
  const int zb = n == 0 ? 128 : 0;
  stage_bf16<384>(kimg, kv0, 2560, false, zb);
  stage_bf16<384>(vimg, kv0 + 256, 2560, true, zb);
  __syncthreads();
  const int t = w * 32 + r, tok = n * 256 + t;
  const int klo = (n == 0 && t + 1 < 128) ? 128 : t + 1, khi = t + 128;
  const int c0 = (32 * w + 1) >> 6, c1 = (32 * w + 159) >> 6;
#pragma unroll 1
  for (int g = 0; g < 3; ++g) {
    const int head = kvh * 3 + g;
    bf16x8 qf[4];
    load_q(qf, p.z + (size_t)tok * 2560 + 512 + head * 64, h);
    float m = p.sinks[head] * LOG2E, l = h == 0 ? 1.f : 0.f;
    f32x16 o[2];
#pragma unroll
    for (int dt = 0; dt < 2; ++dt)
#pragma unroll
      for (int i = 0; i < 16; ++i) o[dt][i] = 0.f;
#pragma unroll 1
    for (int c = c0; c <= c1; ++c) attn_chunk<true>(qf, kimg + c * 8192, vimg + c * 8192, m, l, o, lane, klo - 64 * c, khi - 64 * c);
    attn_store(o, l, lane, true, p.act + (size_t)tok * 1024 + head * 64, p.z + (size_t)tok * 2560 + 1280 + head * 64);
  }
  __syncthreads();
}
template <bool SWA>
DI void stage_wave_kv(char* kimg, char* vimg, const float* ksrc, const float* vsrc, int key0, int nvalid, const bf16* extra, int nextra, int head,
                      float* kcopy, float* vcopy, int lane) {
  f32x4 ka[8], kb[8], va[8], vb[8];
#pragma unroll
  for (int i = 0; i < 8; ++i) {
    const int id = lane + 64 * i, key = id >> 3, kc = id & 7, kk = key0 + key;
    ka[i] = kb[i] = va[i] = vb[i] = (f32x4){0.f, 0.f, 0.f, 0.f};
    if (kk < nvalid) {
      const size_t o = (size_t)kk * 256 + head * 64 + kc * 8;
      ka[i] = *(const f32x4*)(ksrc + o); kb[i] = *(const f32x4*)(ksrc + o + 4);
      va[i] = *(const f32x4*)(vsrc + o); vb[i] = *(const f32x4*)(vsrc + o + 4);
    } else if (SWA && kk - nvalid < nextra) {
      const bf16* e = extra + (size_t)(kk - nvalid) * 2560 + head * 64 + kc * 8;
      ka[i] = __builtin_bit_cast(f32x4, *(const u32x4*)e); va[i] = __builtin_bit_cast(f32x4, *(const u32x4*)(e + 256));
    }
  }
#pragma unroll
  for (int i = 0; i < 8; ++i) {
    const int id = lane + 64 * i, key = id >> 3, kc = id & 7, kk = key0 + key;
    u32x4 tk = __builtin_bit_cast(u32x4, ka[i]), tv = __builtin_bit_cast(u32x4, va[i]);
    if (kk < nvalid) {
      if (SWA && kk >= 8) {
        const size_t o = (size_t)(kk - 8) * 256 + head * 64 + kc * 8;
        *(f32x4*)(kcopy + o) = ka[i]; *(f32x4*)(kcopy + o + 4) = kb[i];
        *(f32x4*)(vcopy + o) = va[i]; *(f32x4*)(vcopy + o + 4) = vb[i];
      }
      tk = (u32x4){pack2(ka[i][0], ka[i][1]), pack2(ka[i][2], ka[i][3]), pack2(kb[i][0], kb[i][1]), pack2(kb[i][2], kb[i][3])};
      tv = (u32x4){pack2(va[i][0], va[i][1]), pack2(va[i][2], va[i][3]), pack2(vb[i][0], vb[i][1]), pack2(vb[i][2], vb[i][3])};
    }
    *(u32x4*)(kimg + key * 128 + ((kc ^ ((key >> 1) & 7)) << 4)) = tk;
    *(u32x4*)(vimg + key * 128 + ((kc ^ (((key >> 1) & 1) << 2)) << 4)) = tv;
  }
}
template <bool SWA>
DI void decode_unit(const Params& p, int layer, int unit, char* smem) {
  const int tid = threadIdx.x, lane = tid & 63, w = tid >> 6, r = lane & 31, h = lane >> 5;
  const int b = unit >> 1, hd = (unit & 1) * 2 + (w >> 2), c = w & 3;
  const int ldz = (SWA || layer) ? 2560 : 2048;
  char* kimg = smem + w * 16384; char* vimg = kimg + 8192;
  const int t = r & 7, g = SWA ? ((r >> 3) > 2 ? 2 : (r >> 3)) : 0;
  const int qhead = SWA ? hd * 3 + g : hd;
  const int qcol = SWA ? 512 : (layer ? 2048 : 1536);
  const int tok = NPR + b * 8 + t;
  bf16x8 qf[4];
  load_q(qf, p.z + (size_t)tok * ldz + qcol + qhead * 64, h);
  const bool active = SWA ? (c < 3) : true;
  if (active) {
    if (SWA) {
      const bf16* knew = p.z + (size_t)(NPR + b * 8) * 2560;
      stage_wave_kv<true>(kimg, vimg, p.cswk + (size_t)b * 32768, p.cswv + (size_t)b * 32768, c * 64, 128, knew, 8, hd,
                          p.out + O_SKS + (size_t)b * 32768, p.out + O_SVS + (size_t)b * 32768, lane);
    } else {
      stage_wave_kv<false>(kimg, vimg, p.cmk + ((size_t)layer * 128 + b) * 65536, p.cmv + ((size_t)layer * 128 + b) * 65536, c * 64, 256, nullptr, 0, hd,
                           nullptr, nullptr, lane);
    }
  }
  __syncthreads();
  float m = -1e30f, l = 0.f;
  if (SWA && c == 0) { m = p.sinks[qhead] * LOG2E; l = h == 0 ? 1.f : 0.f; }
  f32x16 o[2];
#pragma unroll
  for (int dt = 0; dt < 2; ++dt)
#pragma unroll
    for (int i = 0; i < 16; ++i) o[dt][i] = 0.f;
  if (active) attn_chunk<SWA>(qf, kimg, vimg, m, l, o, lane, SWA ? t + 1 - 64 * c : 0, SWA ? t + 128 - 64 * c : 63);
  __syncthreads();
  float* R = (float*)(smem + w * 16384);
  const float lt = l + __shfl_xor(l, 32);
#pragma unroll
  for (int dt = 0; dt < 2; ++dt)
#pragma unroll
    for (int i = 0; i < 16; ++i) R[(dt * 32 + crow(i, h)) * 32 + r] = o[dt][i];
  if (h == 0) { R[2048 + r] = m; R[2080 + r] = lt; }
  __syncthreads();
  const int head2 = tid >> 8, slot = (tid & 255) >> 3, dg = tid & 7;
  if (slot < (SWA ? 24 : 8)) {
    float mc[4], lc[4], M = -1e30f;
#pragma unroll
    for (int cc = 0; cc < 4; ++cc) {
      const float* Rc = (const float*)(smem + (head2 * 4 + cc) * 16384);
      mc[cc] = Rc[2048 + slot]; lc[cc] = Rc[2080 + slot];
      M = fmaxf(M, mc[cc]);
    }
    float L = 0.f, a8[8];
#pragma unroll
    for (int e = 0; e < 8; ++e) a8[e] = 0.f;
#pragma unroll
    for (int cc = 0; cc < 4; ++cc) {
      const float* Rc = (const float*)(smem + (head2 * 4 + cc) * 16384);
      const float wgt = __builtin_amdgcn_exp2f(mc[cc] - M);
      L += wgt * lc[cc];
#pragma unroll
      for (int e = 0; e < 8; ++e) a8[e] += wgt * Rc[(dg * 8 + e) * 32 + slot];
    }
    const float inv = 1.f / L;
    const int hd2 = (unit & 1) * 2 + head2, t2 = slot & 7, g2 = slot >> 3;
    const int tok2 = NPR + b * 8 + t2;
    const int ocol = SWA ? (hd2 * 3 + g2) * 64 : 768 + hd2 * 64;
    const int gcol = SWA ? 1280 + (hd2 * 3 + g2) * 64 : (layer ? 2304 : 1792) + hd2 * 64;
    const u32x4 gg = *(const u32x4*)(p.z + (size_t)tok2 * ldz + gcol + dg * 8);
    u32x4 ov;
#pragma unroll
    for (int e = 0; e < 4; ++e) ov[e] = pack2(a8[2 * e] * inv * bflo(gg[e]), a8[2 * e + 1] * inv * bfhi(gg[e]));
    *(u32x4*)(p.act + (size_t)tok2 * 1024 + ocol + dg * 8) = ov;
  }
  __syncthreads();
}
template <int W>
DI void pool_d_item(const Params& p, int tok, int c0, bf16* __restrict__ dbuf) {
  const bf16* __restrict__ zz = p.z;
  float a[8];
#pragma unroll
  for (int j = 0; j < 8; ++j) a[j] = 0.f;
  u32x4 u0 = {0u, 0u, 0u, 0u};
  float cnt;
  if (tok < NPR) {
    const int nr = tok + 1 < W ? tok + 1 : W;
    cnt = (float)nr;
    u32x4 t[W];
#pragma unroll
    for (int j = 0; j < W; ++j) { const int rr = tok - j < 0 ? 0 : tok - j; t[j] = *(const u32x4*)(zz + (size_t)rr * 2048 + c0); }
    u0 = t[0];
#pragma unroll
    for (int j = 0; j < W; ++j) {
      const float vm = j < nr ? 1.f : 0.f;
#pragma unroll
      for (int e = 0; e < 4; ++e) { a[2 * e] += vm * bflo(t[j][e]); a[2 * e + 1] += vm * bfhi(t[j][e]); }
    }
  } else {
    const int s = tok - NPR, b = s >> 3, t8 = s & 7;
    cnt = (float)W;
    u0 = *(const u32x4*)(zz + (size_t)tok * 2048 + c0);
#pragma unroll
    for (int j = 0; j < W; ++j) {
      const int tt = t8 - j;
      if (tt >= 0) {
        const u32x4 t = *(const u32x4*)(zz + (size_t)(tok - j) * 2048 + c0);
#pragma unroll
        for (int e = 0; e < 4; ++e) { a[2 * e] += bflo(t[e]); a[2 * e + 1] += bfhi(t[e]); }
      } else {
        const float* sp = p.state_pool + (size_t)(b * 15 + 15 + tt) * 768 + c0;
        const f32x4 x0 = *(const f32x4*)sp, x1 = *(const f32x4*)(sp + 4);
        a[0] += x0[0]; a[1] += x0[1]; a[2] += x0[2]; a[3] += x0[3]; a[4] += x1[0]; a[5] += x1[1]; a[6] += x1[2]; a[7] += x1[3];
      }
    }
  }
  const float ic = 1.f / cnt;
  u32x4 o;
#pragma unroll
  for (int e = 0; e < 4; ++e) o[e] = pack2(a[2 * e] * ic - bflo(u0[e]), a[2 * e + 1] * ic - bfhi(u0[e]));
  *(u32x4*)(dbuf + (size_t)tok * 768 + c0) = o;
}

DI void transpose_tile(const float* src, int K, int N, const float* gain, bf16* dst, int tile, char* smem, bool valid) {
  const int tid = threadIdx.x & 255;
  float* T = (float*)(smem + (threadIdx.x >> 8) * 16640);
  const int ntn = N >> 6, k0 = (tile / ntn) << 6, n0 = (tile % ntn) << 6;
  const int c4 = tid & 15, ri = tid >> 4;
  if (valid) {
#pragma unroll
    for (int i = 0; i < 4; ++i) {
      const int k = ri + 16 * i;
      f32x4 t = *(const f32x4*)(src + (size_t)(k0 + k) * N + n0 + c4 * 4);
      const float gsc = gain ? gain[k0 + k] : 1.f;
      T[k * 65 + c4 * 4] = t[0] * gsc; T[k * 65 + c4 * 4 + 1] = t[1] * gsc; T[k * 65 + c4 * 4 + 2] = t[2] * gsc; T[k * 65 + c4 * 4 + 3] = t[3] * gsc;
    }
  }
  __syncthreads();
  const int k8 = tid & 7, nn = tid >> 3;
  if (valid) {
#pragma unroll
    for (int i = 0; i < 2; ++i) {
      const int n = nn + 32 * i;
      const float* tp = T + (k8 * 8) * 65 + n;
      u32x4 o = {pack2(tp[0], tp[65]), pack2(tp[130], tp[195]), pack2(tp[260], tp[325]), pack2(tp[390], tp[455])};
      *(u32x4*)(dst + (size_t)(n0 + n) * K + k0 + k8 * 8) = o;
    }
  }
  __syncthreads();
}
DI void row_prep(const float* src, bf16* dst, float* rstd, int lane) {
  float ss = 0.f;
  f32x4 t[4];
#pragma unroll
  for (int i = 0; i < 4; ++i) { t[i] = *(const f32x4*)(src + i * 256 + lane * 4); ss += t[i][0] * t[i][0] + t[i][1] * t[i][1] + t[i][2] * t[i][2] + t[i][3] * t[i][3]; }
#pragma unroll
  for (int o = 32; o > 0; o >>= 1) ss += __shfl_xor(ss, o);
#pragma unroll
  for (int i = 0; i < 4; ++i) { u32x2 ov = {pack2(t[i][0], t[i][1]), pack2(t[i][2], t[i][3])}; *(u32x2*)(dst + i * 256 + lane * 4) = ov; }
  if (lane == 0) *rstd = rsqrtf(ss * (1.f / 1024.f) + EPS);
}

#define XB_TMO      128
#define XB_XCNT(j)  (256  + 64 * (j))
#define XB_XSUB(j)  (1280 + 64 * (j))
#define XB_XGEN(j)  (2304 + 64 * (j))
#define XB_TOP      3328
#define XB_TOPGEN   3392
#define XCD_BAR_WORDS 3456
#define XB_SPIN_CAP (1u << 18)
#define LAS __attribute__((address_space(3)))
DI unsigned xb_ld(unsigned* p) { return __hip_atomic_load(p, __ATOMIC_RELAXED, __HIP_MEMORY_SCOPE_AGENT); }
DI unsigned xb_add(unsigned* p, unsigned v) { return __hip_atomic_fetch_add(p, v, __ATOMIC_RELAXED, __HIP_MEMORY_SCOPE_AGENT); }
DI unsigned xb_xcc_id() { return (unsigned)__builtin_amdgcn_s_getreg((3 << 11) | 20) & 0xFu; }
#define XB_SPIN(cond, bar) do { unsigned _sp = 0; while (cond) { __builtin_amdgcn_s_sleep(1); \
    if ((++_sp & 255u) == 0u) { if (xb_ld(&(bar)[XB_TMO])) break; if (_sp > XB_SPIN_CAP) { atomicAdd(&(bar)[XB_TMO], 1u); break; } } } } while (0)
struct XcdBarrier { unsigned* bar; unsigned x; volatile LAS unsigned* st; };
DI XcdBarrier xcd_barrier_post(unsigned* bar, volatile LAS unsigned* st) {
  XcdBarrier b; b.bar = bar; b.x = xb_xcc_id(); b.st = st;
  if (threadIdx.x == 0) st[2] = xb_add(&bar[XB_XCNT(b.x)], 1u);
  return b;
}
DI void xcd_barrier_complete(unsigned* bar, unsigned x, unsigned& nloc, unsigned& nx) {
  const unsigned G = gridDim.x * gridDim.y * gridDim.z;
  unsigned sum, cnt, mine, sp = 0u;
  for (;;) {
    sum = 0u; cnt = 0u; mine = 0u;
#pragma unroll
    for (unsigned j = 0; j < 16; ++j) { const unsigned c = xb_ld(&bar[XB_XCNT(j)]); sum += c; cnt += (c > 0u) ? 1u : 0u; mine = (j == x) ? c : mine; }
    if (sum == G) break;
    __builtin_amdgcn_s_sleep(1);
    if ((++sp & 255u) == 0u) { if (xb_ld(&bar[XB_TMO])) break; if (sp > XB_SPIN_CAP) { atomicAdd(&bar[XB_TMO], 1u); break; } }
  }
  nloc = mine > 0u ? mine : 1u; nx = cnt > 0u ? cnt : 1u;
}
DI void xcd_barrier(const XcdBarrier& b) {
  asm volatile("s_waitcnt vmcnt(0)" ::: "memory");
  __syncthreads();
  if (threadIdx.x == 0) {
    unsigned* bar = b.bar;
    __builtin_amdgcn_s_waitcnt(0);
    unsigned nloc = b.st[0], nx = b.st[1];
    if (nloc == 0u) { xcd_barrier_complete(bar, b.x, nloc, nx); b.st[0] = nloc; b.st[1] = nx; }
    const unsigned old = xb_add(&bar[XB_XSUB(b.x)], 1u);
    const unsigned gen = old / nloc;
    if (old + 1u == (gen + 1u) * nloc) {
      __builtin_amdgcn_fence(__ATOMIC_RELEASE, "agent");
      asm volatile("s_waitcnt vmcnt(0)" ::: "memory");
      const unsigned og = xb_add(&bar[XB_TOP], 1u);
      const unsigned tg = og / nx;
      if (og + 1u == (tg + 1u) * nx) xb_add(&bar[XB_TOPGEN], 1u);
      else XB_SPIN(xb_ld(&bar[XB_TOPGEN]) == tg, bar);
      __builtin_amdgcn_fence(__ATOMIC_ACQUIRE, "agent");
      xb_add(&bar[XB_XGEN(b.x)], 1u);
      asm volatile("s_waitcnt vmcnt(0)" ::: "memory");
    } else {
      XB_SPIN(xb_ld(&bar[XB_XGEN(b.x)]) == gen, bar);
      __builtin_amdgcn_fence(__ATOMIC_ACQUIRE, "agent");
      asm volatile("s_waitcnt vmcnt(0)" ::: "memory");
    }
  }
  __syncthreads();
}

template <int PH>
DI void run_phase(const Params& p, char* smem, int vbid) {
  const int bid = blockIdx.x, nb = gridDim.x, tid = threadIdx.x, NT = 512;
  if constexpr (PH == 0) {
    {
      const int lane = tid & 63, w = tid >> 6;
#pragma unroll 1
      for (int u = bid; u < (NTOK + 256) / 16; u += nb) {
        const int row0 = u * 16 + w * 2;
        f32x4 t[2][4];
        const float* src[2]; bf16* dst[2]; float* rs[2];
#pragma unroll
        for (int q = 0; q < 2; ++q) {
          const int row = row0 + q;
          if (row < NTOK) { src[q] = xrow(p, row); dst[q] = p.xb + (size_t)row * 1024; rs[q] = p.rstd_a + row; }
          else { src[q] = p.memp + (size_t)(row - NTOK) * 1024; dst[q] = p.memb + (size_t)(row - NTOK) * 1024; rs[q] = p.rstd_mem + (row - NTOK); }
#pragma unroll
          for (int i = 0; i < 4; ++i) t[q][i] = *(const f32x4*)(src[q] + i * 256 + lane * 4);
        }
#pragma unroll
        for (int q = 0; q < 2; ++q) {
          float ss = 0.f;
#pragma unroll
          for (int i = 0; i < 4; ++i) ss += t[q][i][0] * t[q][i][0] + t[q][i][1] * t[q][i][1] + t[q][i][2] * t[q][i][2] + t[q][i][3] * t[q][i][3];
#pragma unroll
          for (int o = 32; o > 0; o >>= 1) ss += __shfl_xor(ss, o);
#pragma unroll
          for (int i = 0; i < 4; ++i) { u32x2 ov = {pack2(t[q][i][0], t[q][i][1]), pack2(t[q][i][2], t[q][i][3])}; *(u32x2*)(dst[q] + i * 256 + lane * 4) = ov; }
          if (lane == 0) *rs[q] = rsqrtf(ss * (1.f / 1024.f) + EPS);
        }
      }
    }
#pragma unroll 1
    for (int u = bid; u < 978; u += nb) {
      int t = u * 2 + (tid >> 8);
      const float* src; const float* gain = nullptr; bf16* dst; int K = 1024, N = 1024;
      if (t < 512) { src = p.w_in_a; N = 2048; gain = p.norm_a; dst = p.Wt_in_a; }
      else if ((t -= 512) < 256) { src = p.w_out_a; dst = p.Wt_out_a; }
      else if ((t -= 256) < 128) { src = p.w_kv; N = 512; gain = p.kv_norm; dst = p.Wt_kvb; }
      else if ((t -= 128) < 512) { src = p.w_in_b; N = 2048; gain = p.norm_b; dst = p.Wt_kvb + 512 * 1024; }
      else if ((t -= 512) < 256) { src = p.w_out_b; dst = p.Wt_out_b; }
      else if ((t -= 256) < 256) { const int l = t >> 7; t &= 127; src = p.w_mem_kv + (size_t)l * 1024 * 512; N = 512; gain = p.mem_norm + l * 1024; dst = p.Wt_mem + (size_t)l * 512 * 1024; }
      else { t -= 256; const int g = t / 9; t %= 9; src = p.pool_mix_w + (size_t)g * 192 * 192; K = 192; N = 192; dst = p.Wt_pool + (size_t)g * 192 * 768 + g * 192; }
      if (K == 192) {
        const int ltid = tid & 255;
        float* T = (float*)(smem + (tid >> 8) * 16640);
        const int k0 = (t / 3) << 6, n0 = (t % 3) << 6, c4 = ltid & 15, ri = ltid >> 4;
#pragma unroll
        for (int i = 0; i < 4; ++i) {
          const int k = ri + 16 * i;
          f32x4 x = *(const f32x4*)(src + (size_t)(k0 + k) * 192 + n0 + c4 * 4);
          T[k * 65 + c4 * 4] = x[0]; T[k * 65 + c4 * 4 + 1] = x[1]; T[k * 65 + c4 * 4 + 2] = x[2]; T[k * 65 + c4 * 4 + 3] = x[3];
        }
      }
      if (K != 192) transpose_tile(src, K, N, gain, dst, t, smem, true);
      else {
        __syncthreads();
        const int ltid = tid & 255, k8 = ltid & 7, nn = ltid >> 3;
        const float* T = (const float*)(smem + (tid >> 8) * 16640);
        const int k0 = (t / 3) << 6, n0 = (t % 3) << 6;
#pragma unroll
        for (int i = 0; i < 2; ++i) {
          const int n = nn + 32 * i;
          const float* tp = T + (k8 * 8) * 65 + n;
          u32x4 o = {pack2(tp[0], tp[65]), pack2(tp[130], tp[195]), pack2(tp[260], tp[325]), pack2(tp[390], tp[455])};
          *(u32x4*)(dst + (size_t)(n0 + n) * 768 + k0 + k8 * 8) = o;
        }
        __syncthreads();
      }
    }
    for (int i = bid * NT + tid; i < 768 * 96; i += nb * NT) {
      const int n = i / 96, k8 = i % 96;
      if (n / 192 != k8 / 24) { u32x4 zz = {0u, 0u, 0u, 0u}; *(u32x4*)(p.Wt_pool + (size_t)n * 768 + k8 * 8) = zz; }
    }
    for (int i = bid * NT + tid; i < NTOK; i += nb * NT) p.ssq1[i] = 0.f;
    for (int i = bid * NT + tid; i < 128 * 7 * 192; i += nb * NT) {
      const int b = i / (7 * 192), rem = i % (7 * 192);
      *(f32x4*)(p.out + O_POOLS + (size_t)b * 15 * 768 + rem * 4) = *(const f32x4*)(p.state_pool + (size_t)b * 15 * 768 + 8 * 768 + rem * 4);
    }
  } else if constexpr (PH == 1) {
    gemm_phase(p.xb, 1024, p.Wt_in_a, 1024, 16, 68, 8, smem, EpiInA{p}, vbid);
#pragma unroll 1
    for (int v = nb - 1 - ((nb & 255) == 0 ? ((vbid & 31) * (nb >> 5) + (vbid >> 5)) : vbid); v < 16; v += nb) gemm_tile<128, 128>(p.memb, 1024, p.Wt_mem, 1024, 16, (v >> 3) * 128, (v & 7) * 128, smem, EpiMemKV{p});
  } else if constexpr (PH == 2) {
#pragma unroll 1
    for (int u = bid; u < 256; u += nb) mem_attn_prompt(p, 0, u, smem);
    {
      bf16* dbuf = p.dbuf;
      const int lane = tid & 63, gw = bid * 8 + (tid >> 6), nw = nb * 8;
#pragma unroll 1
      for (int it = gw; it < (NTOK / 8) * 4; it += nw) {
        const int tg = it >> 2, g = it & 3;
        const int tok = tg * 8 + (lane >> 3), c0 = g * 192 + (lane & 7) * 8;
        if (g == 0) { pool_d_item<2>(p, tok, c0, dbuf); pool_d_item<2>(p, tok, c0 + 64, dbuf); pool_d_item<2>(p, tok, c0 + 128, dbuf); }
        else if (g == 1) { pool_d_item<4>(p, tok, c0, dbuf); pool_d_item<4>(p, tok, c0 + 64, dbuf); pool_d_item<4>(p, tok, c0 + 128, dbuf); }
        else if (g == 2) { pool_d_item<8>(p, tok, c0, dbuf); pool_d_item<8>(p, tok, c0 + 64, dbuf); pool_d_item<8>(p, tok, c0 + 128, dbuf); }
        else { pool_d_item<16>(p, tok, c0, dbuf); pool_d_item<16>(p, tok, c0 + 64, dbuf); pool_d_item<16>(p, tok, c0 + 128, dbuf); }
      }
    }
  } else if constexpr (PH == 3) {
    const int vb = vbid, NG = 68 * 3;
    if (nb >= NG + 32) {
      if (vb < NG) {
        const int mt = vb / 3, nt = vb % 3;
        gemm_tile<256, 256>(p.dbuf + nt * 192, 768, p.Wt_pool + nt * 192, 768, 6, mt * 256, nt * 256, smem, EpiPool{p});
      } else {
#pragma unroll 1
        for (int u = vb - NG; u < 256; u += nb - NG) decode_unit<false>(p, 0, u, smem);
      }
    } else {
#pragma unroll 1
      for (int u = vb; u < NG; u += nb) {
        const int mt = u / 3, nt = u % 3;
        gemm_tile<256, 256>(p.dbuf + nt * 192, 768, p.Wt_pool + nt * 192, 768, 6, mt * 256, nt * 256, smem, EpiPool{p});
      }
#pragma unroll 1
      for (int u = bid; u < 256; u += nb) decode_unit<false>(p, 0, u, smem);
    }
  } else if constexpr (PH == 4) {
    gemm_phase(p.act, 1024, p.Wt_out_a, 1024, 16, 68, 4, smem, EpiOutA{p}, vbid);
  } else if constexpr (PH == 5) {
    gemm_phase(p.xb, 1024, p.Wt_kvb, 1024, 16, 68, 10, smem, EpiKVB{p}, vbid);
  } else if constexpr (PH == 6) {
#pragma unroll 1
    for (int u = bid; u < 256; u += nb) swa_prompt(p, u, smem);
#pragma unroll 1
    for (int u = bid; u < 256; u += nb) mem_attn_prompt(p, 1, u, smem);
#pragma unroll 1
    for (int u = bid; u < 256; u += nb) decode_unit<true>(p, 1, u, smem);
#pragma unroll 1
    for (int u = bid; u < 256; u += nb) decode_unit<false>(p, 1, u, smem);
  } else if constexpr (PH == 7) {
    gemm_phase(p.act, 1024, p.Wt_out_b, 1024, 16, 68, 4, smem, EpiOutB{p}, vbid);
  }
}

#if MULTI_LAUNCH
template <int PH>
__global__ void __launch_bounds__(512) phase_kernel(Params p) {
  __shared__ __attribute__((aligned(1024))) char smem[135168];
  run_phase<PH>(p, smem, blockIdx.x);
}
#else
__global__ void __launch_bounds__(512) yoco_megakernel(Params p) {
  __shared__ __attribute__((aligned(1024))) char smem[135168];
  __shared__ uint4 xb_words;
  if (threadIdx.x == 0) xb_words = make_uint4(0u, 0u, 0u, 0u);
  __syncthreads();
  XcdBarrier xb = xcd_barrier_post(p.bar, (volatile LAS unsigned*)&xb_words);
  run_phase<0>(p, smem, blockIdx.x); xcd_barrier(xb);
  if (threadIdx.x == 0) {
    const unsigned per = gridDim.x >> 3;
    bool even = (gridDim.x & 7u) == 0u;
    for (unsigned j = 0; j < 16; ++j) { const unsigned c = xb_ld(&p.bar[XB_XCNT(j)]); even = even && (j < 8 ? c == per : c == 0u); }
    const unsigned rank = ((volatile LAS unsigned*)&xb_words)[2];
    ((volatile LAS unsigned*)&xb_words)[3] = even ? xb.x * per + rank : blockIdx.x;
  }
  __syncthreads();
  const int vbid = (int)((volatile LAS unsigned*)&xb_words)[3];
  run_phase<1>(p, smem, vbid); xcd_barrier(xb);
  run_phase<2>(p, smem, vbid); xcd_barrier(xb);
  run_phase<3>(p, smem, vbid); xcd_barrier(xb);
  run_phase<4>(p, smem, vbid); xcd_barrier(xb);
  run_phase<5>(p, smem, vbid); xcd_barrier(xb);
  run_phase<6>(p, smem, vbid); xcd_barrier(xb);
  run_phase<7>(p, smem, vbid);
}
#endif

extern "C" void kernel_launch(void* const* d_in, const int* in_sizes, int n_in, void* d_out, int out_size, void* d_ws, size_t ws_size, hipStream_t stream) {
  Params p{};
  const float* const* in = (const float* const*)d_in;
  p.xp = in[0]; p.xs = in[1]; p.state_pool = in[2]; p.cswk = in[3]; p.cswv = in[4]; p.cmk = in[5]; p.cmv = in[6]; p.memp = in[7];
  p.norm_a = in[8]; p.w_in_a = in[9]; p.pool_mix_w = in[10]; p.pool_scale = in[11]; p.w_out_a = in[12]; p.kv_norm = in[13]; p.w_kv = in[14];
  p.k_norm = in[15]; p.norm_b = in[16]; p.w_in_b = in[17]; p.q_norm = in[18]; p.sinks = in[19]; p.w_out_b = in[20]; p.mem_norm = in[21];
  p.w_mem_kv = in[22]; p.mem_q_norm = in[23]; p.mem_k_norm = in[24];
  p.out = (float*)d_out;
  char* ws = (char*)d_ws;
  size_t off = 0;
  auto take = [&](size_t bytes) { char* r = ws + off; off += (bytes + 255) & ~(size_t)255; return r; };
  p.Wt_in_a = (bf16*)take((size_t)2048 * 1024 * 2);
  p.Wt_out_a = (bf16*)take((size_t)1024 * 1024 * 2);
  p.Wt_kvb = (bf16*)take((size_t)2560 * 1024 * 2);
  p.Wt_out_b = (bf16*)take((size_t)1024 * 1024 * 2);
  p.Wt_mem = (bf16*)take((size_t)1024 * 1024 * 2);
  p.Wt_pool = (bf16*)take((size_t)768 * 768 * 2);
  p.memb = (bf16*)take((size_t)256 * 1024 * 2);
  p.mkb = (bf16*)take((size_t)4 * 256 * 256 * 2);
  p.rstd_a = (float*)take((size_t)NTOK * 4);
  p.rstd_mem = (float*)take(256 * 4);
  p.ssq1 = (float*)take((size_t)NTOK * 4);
  p.bar = (unsigned*)take((size_t)XCD_BAR_WORDS * 4);
  p.xb = (bf16*)take((size_t)NTOK * 1024 * 2);
  p.act = (bf16*)take((size_t)NTOK * 1024 * 2);
  p.dbuf = (bf16*)take((size_t)NTOK * 768 * 2);
  p.z = (bf16*)take((size_t)NTOK * 2560 * 2);
  for (int i = 0; i < 8; ++i) p.rope_inv[i] = powf(500000.0f, -(float)i / 8.0f);
#if MULTI_LAUNCH
  const int grid = 256;
  phase_kernel<0><<<grid, 512, 0, stream>>>(p);
  phase_kernel<1><<<grid, 512, 0, stream>>>(p);
  phase_kernel<2><<<grid, 512, 0, stream>>>(p);
  phase_kernel<3><<<grid, 512, 0, stream>>>(p);
  phase_kernel<4><<<grid, 512, 0, stream>>>(p);
  phase_kernel<5><<<grid, 512, 0, stream>>>(p);
  phase_kernel<6><<<grid, 512, 0, stream>>>(p);
  phase_kernel<7><<<grid, 512, 0, stream>>>(p);
#else
  static int grid_blocks = 0;
  if (!grid_blocks) {
    int dev = 0, cus = 0, per_cu = 0;
    hipGetDevice(&dev);
    hipDeviceGetAttribute(&cus, hipDeviceAttributeMultiprocessorCount, dev);
    (void)hipOccupancyMaxActiveBlocksPerMultiprocessor(&per_cu, yoco_megakernel, 512, 0);
    if (per_cu > 1) per_cu = 1;
    grid_blocks = cus * per_cu;
  }
  (void)hipMemsetAsync(p.bar, 0, (size_t)XCD_BAR_WORDS * 4, stream);
  void* args[] = {&p};
  hipError_t e = hipLaunchCooperativeKernel((void*)yoco_megakernel, dim3(grid_blocks), dim3(512), args, 0, stream);
  if (e != hipSuccess) fprintf(stderr, "cooperative launch failed: %s (grid %d)\n", hipGetErrorString(e), grid_blocks);
#endif
}
```

```cpp
#include <hip/hip_runtime.h>
#include <hip/hip_cooperative_groups.h>
#include <cstdio>
#include <cmath>
namespace cg = cooperative_groups;

#ifndef MULTI_LAUNCH
#define MULTI_LAUNCH 0
#endif

typedef unsigned short bf16;
typedef short bf16x8 __attribute__((ext_vector_type(8)));
typedef short s16x4 __attribute__((ext_vector_type(4)));
typedef float f32x16 __attribute__((ext_vector_type(16)));
typedef float f32x4 __attribute__((ext_vector_type(4)));
typedef unsigned u32x4 __attribute__((ext_vector_type(4)));
typedef unsigned u32x2 __attribute__((ext_vector_type(2)));
#define DI __device__ __forceinline__
#define MFMA32(a, b, c) __builtin_amdgcn_mfma_f32_32x32x16_bf16((a), (b), (c), 0, 0, 0)

constexpr int NTOK = 17408, NPR = 16384, DM = 1024;
constexpr float EPS = 1e-6f;
constexpr float LOG2E = 1.4426950408889634f;
constexpr size_t O_Y = 0, O_POOLP = 17825792, O_POOLS = 17837312, O_SKP = 19311872, O_SVP = 19344640,
                 O_SKS = 19377408, O_SVS = 23571712, O_MKP = 27766016, O_MVP = 27897088;

struct Params {
  const float *xp, *xs, *state_pool, *cswk, *cswv, *cmk, *cmv, *memp;
  const float *norm_a, *w_in_a, *pool_mix_w, *pool_scale, *w_out_a, *kv_norm, *w_kv, *k_norm, *norm_b, *w_in_b, *q_norm,
      *sinks, *w_out_b, *mem_norm, *w_mem_kv, *mem_q_norm, *mem_k_norm;
  float* out;
  bf16 *Wt_in_a, *Wt_out_a, *Wt_kvb, *Wt_out_b, *Wt_mem, *Wt_pool;
  bf16 *xb, *act, *z, *memb, *mkb, *dbuf;
  float *rstd_a, *rstd_mem, *ssq1;
  unsigned* bar;
  float rope_inv[8];
};

DI unsigned pack2(float a, float b) {
  typedef __bf16 bf2 __attribute__((ext_vector_type(2)));
  typedef float f2 __attribute__((ext_vector_type(2)));
  f2 f = {a, b};
  return __builtin_bit_cast(unsigned, __builtin_convertvector(f, bf2));
}
DI float bflo(unsigned u) { return __uint_as_float(u << 16); }
DI float bfhi(unsigned u) { return __uint_as_float(u & 0xffff0000u); }
DI float silu(float x) { return x * __builtin_amdgcn_rcpf(1.f + __builtin_amdgcn_exp2f(-LOG2E * x)); }
DI int crow(int i, int h) { return (i & 3) + 8 * (i >> 2) + 4 * h; }
DI const float* xrow(const Params& p, int tok) { return tok < NPR ? p.xp + (size_t)tok * DM : p.xs + (size_t)(tok - NPR) * DM; }

template <int MI, int NI>
DI void frag_read(u32x4 (&fa)[MI], u32x4 (&fb)[NI], unsigned ab, unsigned bb) {
  if constexpr (MI == 4 && NI == 2) {
    asm volatile("ds_read_b128 %0, %6\n\tds_read_b128 %1, %6 offset:2048\n\tds_read_b128 %2, %6 offset:4096\n\tds_read_b128 %3, %6 offset:6144\n\t"
                 "ds_read_b128 %4, %7\n\tds_read_b128 %5, %7 offset:2048"
                 : "=&v"(fa[0]), "=&v"(fa[1]), "=&v"(fa[2]), "=&v"(fa[3]), "=&v"(fb[0]), "=&v"(fb[1]) : "v"(ab), "v"(bb) : "memory");
  } else {
    static_assert((MI == 4 && NI == 2) || (MI == 2 && NI == 1), "tile config");
    asm volatile("ds_read_b128 %0, %3\n\tds_read_b128 %1, %3 offset:2048\n\tds_read_b128 %2, %4"
                 : "=&v"(fa[0]), "=&v"(fa[1]), "=&v"(fb[0]) : "v"(ab), "v"(bb) : "memory");
  }
}
template <int KEEP, int MI, int NI>
DI void frag_wait(u32x4 (&fa)[MI], u32x4 (&fb)[NI]) {
  if constexpr (MI == 4 && NI == 2)
    asm volatile("s_waitcnt lgkmcnt(%6)" : "+v"(fa[0]), "+v"(fa[1]), "+v"(fa[2]), "+v"(fa[3]), "+v"(fb[0]), "+v"(fb[1]) : "n"(KEEP) : "memory");
  else
    asm volatile("s_waitcnt lgkmcnt(%3)" : "+v"(fa[0]), "+v"(fa[1]), "+v"(fb[0]) : "n"(KEEP) : "memory");
}
template <int BM, int BN, class Epi>
DI void gemm_tile(const bf16* __restrict__ A, int lda, const bf16* __restrict__ Bt, int ldb, int nk64, int m0, int n0, char* smem, const Epi& epi) {
  constexpr int RW = BM / 2, CW = BN / 4, MI = RW / 32, NI = CW / 32;
  constexpr int A_BYTES = BM * 64, B_BYTES = BN * 64, STAGE = A_BYTES + B_BYTES, GA = BM / 128, GB = BN / 128, GT = GA + GB;
  const int nk = nk64 * 2;
  const int tid = threadIdx.x, lane = tid & 63, w = tid >> 6;
  const int wm = w >> 2, wn = w & 3, r = lane & 31, h = lane >> 5;
  f32x16 acc[MI][NI];
#pragma unroll
  for (int mi = 0; mi < MI; ++mi)
#pragma unroll
    for (int ni = 0; ni < NI; ++ni)
#pragma unroll
      for (int i = 0; i < 16; ++i) acc[mi][ni][i] = 0.f;
  const int srow = w * 16 + (lane >> 2);
  const int slc = (lane & 3) ^ ((srow >> 2) & 3);
  const bf16* Ag = A + (size_t)(m0 + srow) * lda + slc * 8;
  const bf16* Bg = Bt + (size_t)(n0 + srow) * ldb + slc * 8;
#define GEMM_STAGE(buf, kt)                                                                                                        \
  do {                                                                                                                             \
    char* sa_ = smem + (buf) * STAGE + w * 1024;                                                                                   \
    _Pragma("unroll") for (int i = 0; i < GA; ++i)                                                                                 \
        __builtin_amdgcn_global_load_lds((const unsigned*)(Ag + (size_t)(128 * i) * lda + (kt) * 32), (unsigned*)(sa_ + i * 8192), 16, 0, 0); \
    _Pragma("unroll") for (int i = 0; i < GB; ++i)                                                                                 \
        __builtin_amdgcn_global_load_lds((const unsigned*)(Bg + (size_t)(128 * i) * ldb + (kt) * 32), (unsigned*)(sa_ + A_BYTES + i * 8192), 16, 0, 0); \
  } while (0)
#define WAIT_V(n) asm volatile("s_waitcnt vmcnt(%0)" ::"n"(n) : "memory")
  asm volatile("s_waitcnt vmcnt(0)" ::: "memory");
  GEMM_STAGE(0, 0);
  GEMM_STAGE(1, 1);
  GEMM_STAGE(2, 2);
  int aoff[MI], boff[NI];
#pragma unroll
  for (int mi = 0; mi < MI; ++mi) { const int row = wm * RW + mi * 32 + r; aoff[mi] = row * 64 + ((h ^ ((row >> 2) & 3)) << 4); }
#pragma unroll
  for (int ni = 0; ni < NI; ++ni) { const int row = wn * CW + ni * 32 + r; boff[ni] = A_BYTES + row * 64 + ((h ^ ((row >> 2) & 3)) << 4); }
  constexpr int RD = MI + NI;
  const unsigned sb0 = (unsigned)(size_t)smem;
  u32x4 fa0[MI], fb0[NI], fa1[MI], fb1[NI];
#define GEMM_MMA(FA, FB)                                                                                   \
  _Pragma("unroll") for (int mi = 0; mi < MI; ++mi) _Pragma("unroll") for (int ni = 0; ni < NI; ++ni)      \
      acc[mi][ni] = MFMA32(__builtin_bit_cast(bf16x8, FB[ni]), __builtin_bit_cast(bf16x8, FA[mi]), acc[mi][ni])
  WAIT_V(2 * GT);
  __builtin_amdgcn_s_barrier();
  asm volatile("" ::: "memory");
  frag_read<MI, NI>(fa0, fb0, sb0 + (unsigned)aoff[0], sb0 + (unsigned)boff[0]);
#pragma unroll 1
  for (int kt = 0; kt < nk - 1; ++kt) {
    if (kt + 2 < nk) WAIT_V(GT); else WAIT_V(0);
    __builtin_amdgcn_s_barrier();
    asm volatile("" ::: "memory");
    if (kt + 3 < nk) GEMM_STAGE((kt + 3) & 3, kt + 3);
    const unsigned sc = sb0 + (unsigned)((kt & 3) * STAGE), sn = sb0 + (unsigned)(((kt + 1) & 3) * STAGE);
    frag_read<MI, NI>(fa1, fb1, (sc + (unsigned)aoff[0]) ^ 32u, (sc + (unsigned)boff[0]) ^ 32u);
    frag_wait<RD, MI, NI>(fa0, fb0);
    GEMM_MMA(fa0, fb0);
    frag_read<MI, NI>(fa0, fb0, sn + (unsigned)aoff[0], sn + (unsigned)boff[0]);
    frag_wait<RD, MI, NI>(fa1, fb1);
    GEMM_MMA(fa1, fb1);
  }
  {
    const unsigned sc = sb0 + (unsigned)(((nk - 1) & 3) * STAGE);
    frag_read<MI, NI>(fa1, fb1, (sc + (unsigned)aoff[0]) ^ 32u, (sc + (unsigned)boff[0]) ^ 32u);
    frag_wait<RD, MI, NI>(fa0, fb0);
    GEMM_MMA(fa0, fb0);
    frag_wait<0, MI, NI>(fa1, fb1);
    GEMM_MMA(fa1, fb1);
  }
#undef GEMM_MMA
#undef GEMM_STAGE
#undef WAIT_V
  __syncthreads();
  constexpr int CPB = (BN + 8) * 2, SEGS = BN / 32, ITEMS = BM * SEGS / 512;
#pragma unroll
  for (int mi = 0; mi < MI; ++mi)
#pragma unroll
    for (int ni = 0; ni < NI; ++ni)
#pragma unroll
      for (int g = 0; g < 4; ++g) {
        const int row = wm * RW + mi * 32 + r, col = wn * CW + ni * 32 + 8 * g + 4 * h;
        u32x2 pk = {pack2(acc[mi][ni][4 * g], acc[mi][ni][4 * g + 1]), pack2(acc[mi][ni][4 * g + 2], acc[mi][ni][4 * g + 3])};
        *(u32x2*)(smem + row * CPB + col * 2) = pk;
      }
  __syncthreads();
  typename Epi::Pre pre[ITEMS];
#pragma unroll
  for (int it = 0; it < ITEMS; ++it) {
    const int item = it * 512 + tid, prow = item / SEGS, seg = item % SEGS;
    epi.prefetch(m0 + prow, n0 + seg * 32, pre[it]);
  }
#pragma unroll
  for (int it = 0; it < ITEMS; ++it) {
    const int item = it * 512 + tid, prow = item / SEGS, seg = item % SEGS;
    float v[32];
#pragma unroll
    for (int j = 0; j < 4; ++j) {
      const u32x4 t = *(const u32x4*)(smem + prow * CPB + seg * 64 + 16 * j);
#pragma unroll
      for (int e = 0; e < 4; ++e) { v[8 * j + 2 * e] = bflo(t[e]); v[8 * j + 2 * e + 1] = bfhi(t[e]); }
    }
    epi(m0 + prow, n0 + seg * 32, v, pre[it]);
    if constexpr (Epi::LDS_OUT) {
#pragma unroll
      for (int j = 0; j < 4; ++j) {
        u32x4 o = {pack2(v[8 * j], v[8 * j + 1]), pack2(v[8 * j + 2], v[8 * j + 3]), pack2(v[8 * j + 4], v[8 * j + 5]), pack2(v[8 * j + 6], v[8 * j + 7])};
        *(u32x4*)(smem + prow * CPB + seg * 64 + 16 * j) = o;
      }
    }
  }
  __syncthreads();
  if constexpr (Epi::LDS_OUT) {
    constexpr int CH = BN / 8, NIT = BM * CH / 512;
    bf16* ob = epi.out_base() + (size_t)m0 * epi.out_ld() + n0;
    const int ld = epi.out_ld();
#pragma unroll 4
    for (int it = 0; it < NIT; ++it) {
      const int idx = it * 512 + tid, row = idx / CH, c8 = idx % CH;
      const u32x4 t = *(const u32x4*)(smem + row * CPB + c8 * 16);
      *(u32x4*)(ob + (size_t)row * ld + c8 * 8) = t;
    }
    __syncthreads();
  }
}
template <class Epi>
DI void gemm_phase(const bf16* A, int lda, const bf16* Bt, int ldb, int nk, int MT, int NT, char* smem, const Epi& epi, int g_vb) {
  const int nb = gridDim.x;
  const int vb = g_vb;
  const int U = MT * NT, full = (U / nb) * nb, rem = U - full;
#pragma unroll 1
  for (int u = vb; u < full; u += nb) gemm_tile<256, 256>(A, lda, Bt, ldb, nk, (u / NT) * 256, (u % NT) * 256, smem, epi);
  if (rem * 4 <= nb) {
    const int tvb = (nb & 255) == 0 ? ((vb & 31) * (nb >> 5) + (vb >> 5)) : vb;
#pragma unroll 1
    for (int sidx = tvb; sidx < rem * 4; sidx += nb) {
      const int u = full + (sidx >> 2), q = sidx & 3;
      gemm_tile<128, 128>(A, lda, Bt, ldb, nk, (u / NT) * 256 + (q >> 1) * 128, (u % NT) * 256 + (q & 1) * 128, smem, epi);
    }
  } else {
#pragma unroll 1
    for (int u = full + vb; u < U; u += nb) gemm_tile<256, 256>(A, lda, Bt, ldb, nk, (u / NT) * 256, (u % NT) * 256, smem, epi);
  }
}

template <int NC>
DI void store_bf16(bf16* dst, const float (&v)[NC]) {
#pragma unroll
  for (int j = 0; j < NC / 8; ++j) {
    u32x4 o = {pack2(v[8 * j], v[8 * j + 1]), pack2(v[8 * j + 2], v[8 * j + 3]), pack2(v[8 * j + 4], v[8 * j + 5]), pack2(v[8 * j + 6], v[8 * j + 7])};
    *(u32x4*)(dst + 8 * j) = o;
  }
}
template <int NC>
DI void store_f32(float* dst, const float (&v)[NC]) {
#pragma unroll
  for (int j = 0; j < NC / 4; ++j) { f32x4 o = {v[4 * j], v[4 * j + 1], v[4 * j + 2], v[4 * j + 3]}; *(f32x4*)(dst + 4 * j) = o; }
}
DI void head_rmsnorm(float (&v)[32], const float* gain, int hoff, float post) {
  float ss = 0.f;
#pragma unroll
  for (int j = 0; j < 32; ++j) ss += v[j] * v[j];
  ss += __shfl_xor(ss, 1);
  const float rs = rsqrtf(ss * (1.f / 64.f) + EPS) * post;
#pragma unroll
  for (int j = 0; j < 32; ++j) v[j] = v[j] * rs * gain[hoff + j];
}
DI void rope16(float (&v)[32], int pos, const float* inv) {
#pragma unroll
  for (int i = 0; i < 8; ++i) {
    double rev = (double)pos * (double)inv[i] * 0.15915494309189535;
    rev -= floor(rev);
    const float fr = (float)rev;
    const float sn = __builtin_amdgcn_sinf(fr), cs = __builtin_amdgcn_cosf(fr);
    const float a = v[i], b = v[i + 8];
    v[i] = a * cs - b * sn;
    v[i + 8] = b * cs + a * sn;
  }
}

struct EpiInA {
  static constexpr bool LDS_OUT = true;
  DI bf16* out_base() const { return p.z; }
  DI int out_ld() const { return 2048; }
  const Params& p;
  struct Pre { float rs; };
  DI void prefetch(int row, int col, Pre& q) const { q.rs = p.rstd_a[row]; }
  DI void operator()(int row, int col, float (&v)[32], const Pre& q) const {
    const float rs = q.rs;
#pragma unroll
    for (int j = 0; j < 32; ++j) v[j] *= rs;
    if (col < 768) {
      if (row >= NPR - 15) {
        if (row < NPR) store_f32<32>(p.out + O_POOLP + (size_t)(row - (NPR - 15)) * 768 + col, v);
        else { const int s = row - NPR, b = s >> 3, t = s & 7; store_f32<32>(p.out + O_POOLS + (size_t)(b * 15 + 7 + t) * 768 + col, v); }
      }
    } else if (col < 1536) {
#pragma unroll
      for (int j = 0; j < 32; ++j) v[j] = silu(v[j]);
    } else if (col < 1792) {
      head_rmsnorm(v, p.mem_q_norm, col & 63, 0.125f * LOG2E);
    } else {
#pragma unroll
      for (int j = 0; j < 32; ++j) v[j] = silu(v[j]);
    }
  }
};
struct EpiMemKV {
  static constexpr bool LDS_OUT = false;
  DI bf16* out_base() const { return nullptr; }
  DI int out_ld() const { return 0; }
  const Params& p;
  struct Pre { float rs; };
  DI void prefetch(int row, int col, Pre& q) const { q.rs = p.rstd_mem[row]; }
  DI void operator()(int row, int col, float (&v)[32], const Pre& q) const {
    const float rs = q.rs;
#pragma unroll
    for (int j = 0; j < 32; ++j) v[j] *= rs;
    const int l = col >> 9, wi = col & 511;
    const bool isk = wi < 256;
    if (isk) head_rmsnorm(v, p.mem_k_norm + l * 64, col & 63, 1.f);
    const size_t e = (size_t)(l * 256 + row) * 256 + (wi & 255) + (isk ? 0 : 131072);
    store_f32<32>(p.out + O_MKP + e, v);
    store_bf16<32>(p.mkb + e, v);
  }
};
struct EpiPool {
  static constexpr bool LDS_OUT = false;
  DI bf16* out_base() const { return nullptr; }
  DI int out_ld() const { return 0; }
  const Params& p;
  struct Pre { u32x4 g[4]; };
  DI void prefetch(int row, int col, Pre& pq) const {
    const bf16* gp = p.z + (size_t)row * 2048 + 768 + col;
#pragma unroll
    for (int q = 0; q < 4; ++q) pq.g[q] = *(const u32x4*)(gp + 8 * q);
  }
  DI void operator()(int row, int col, float (&v)[32], const Pre& pq) const {
    const float* sc = p.pool_scale + col;
#pragma unroll
    for (int q = 0; q < 4; ++q) {
      const u32x4 g = pq.g[q];
#pragma unroll
      for (int j = 0; j < 4; ++j) { v[8 * q + 2 * j] *= sc[8 * q + 2 * j] * bflo(g[j]); v[8 * q + 2 * j + 1] *= sc[8 * q + 2 * j + 1] * bfhi(g[j]); }
    }
    store_bf16<32>(p.act + (size_t)row * 1024 + col, v);
  }
};
struct EpiOutA {
  static constexpr bool LDS_OUT = false;
  DI bf16* out_base() const { return nullptr; }
  DI int out_ld() const { return 0; }
  const Params& p;
  struct Pre { u32x4 x[4]; };
  DI void prefetch(int row, int col, Pre& q) const {
    const bf16* xr = p.xb + (size_t)row * 1024 + col;
#pragma unroll
    for (int j = 0; j < 4; ++j) q.x[j] = *(const u32x4*)(xr + 8 * j);
  }
  DI void operator()(int row, int col, float (&v)[32], const Pre& q) const {
    float ss = 0.f;
#pragma unroll
    for (int j = 0; j < 4; ++j)
#pragma unroll
      for (int e = 0; e < 4; ++e) { v[8 * j + 2 * e] += bflo(q.x[j][e]); v[8 * j + 2 * e + 1] += bfhi(q.x[j][e]); }
#pragma unroll
    for (int j = 0; j < 32; ++j) ss += v[j] * v[j];
    ss += __shfl_xor(ss, 1);
    ss += __shfl_xor(ss, 2);
    if ((threadIdx.x & 3) == 0) atomicAdd(p.ssq1 + row, ss);
    store_bf16<32>(p.xb + (size_t)row * 1024 + col, v);
  }
};
struct EpiKVB {
  static constexpr bool LDS_OUT = true;
  DI bf16* out_base() const { return p.z; }
  DI int out_ld() const { return 2560; }
  const Params& p;
  struct Pre { float ssq; };
  DI void prefetch(int row, int col, Pre& q) const { q.ssq = p.ssq1[row]; }
  DI void operator()(int row, int col, float (&v)[32], const Pre& q) const {
    const float rs = rsqrtf(q.ssq * (1.f / 1024.f) + EPS);
#pragma unroll
    for (int j = 0; j < 32; ++j) v[j] *= rs;
    const int pos = row < NPR ? row : NPR + ((row - NPR) & 7);
    if (col < 512) {
      if (col < 256) {
        head_rmsnorm(v, p.k_norm, col & 63, 1.f);
        if ((col & 63) == 0) rope16(v, pos, p.rope_inv);
      }
      const size_t ob = col < 256 ? 0 : (O_SVP - O_SKP);
      const size_t obs = col < 256 ? 0 : (O_SVS - O_SKS);
      const int c = col & 255;
      if (row >= NPR - 128) {
        if (row < NPR) store_f32<32>(p.out + O_SKP + ob + (size_t)(row - (NPR - 128)) * 256 + c, v);
        else { const int s = row - NPR, b = s >> 3, t = s & 7; store_f32<32>(p.out + O_SKS + obs + (size_t)(b * 128 + 120 + t) * 256 + c, v); }
      }
    } else if (col < 1280) {
      head_rmsnorm(v, p.q_norm, col & 63, 0.125f * LOG2E);
      if ((col & 63) == 0) rope16(v, pos, p.rope_inv);
    } else if (col < 2048) {
#pragma unroll
      for (int j = 0; j < 32; ++j) v[j] = silu(v[j]);
    } else if (col < 2304) {
      head_rmsnorm(v, p.mem_q_norm + 64, col & 63, 0.125f * LOG2E);
    } else {
#pragma unroll
      for (int j = 0; j < 32; ++j) v[j] = silu(v[j]);
    }
  }
};
struct EpiOutB {
  static constexpr bool LDS_OUT = false;
  DI bf16* out_base() const { return nullptr; }
  DI int out_ld() const { return 0; }
  const Params& p;
  struct Pre { u32x4 x[4]; };
  DI void prefetch(int row, int col, Pre& q) const {
    const bf16* xr = p.xb + (size_t)row * 1024 + col;
#pragma unroll
    for (int j = 0; j < 4; ++j) q.x[j] = *(const u32x4*)(xr + 8 * j);
  }
  DI void operator()(int row, int col, float (&v)[32], const Pre& q) const {
#pragma unroll
    for (int j = 0; j < 4; ++j)
#pragma unroll
      for (int e = 0; e < 4; ++e) { v[8 * j + 2 * e] += bflo(q.x[j][e]); v[8 * j + 2 * e + 1] += bfhi(q.x[j][e]); }
    store_f32<32>(p.out + O_Y + (size_t)row * 1024 + col, v);
  }
};

template <bool MASKED>
DI void attn_chunk(const bf16x8 (&qf)[4], const char* kimg, const char* vimg, float& m, float& l, f32x16 (&o)[2], int lane, int lo, int hi) {
  const int r = lane & 31, h = lane >> 5;
  f32x16 s[2];
#pragma unroll
  for (int kt = 0; kt < 2; ++kt) {
#pragma unroll
    for (int i = 0; i < 16; ++i) s[kt][i] = 0.f;
#pragma unroll
    for (int ks = 0; ks < 4; ++ks) {
      const int row = kt * 32 + r, chunk = ks * 2 + h;
      const bf16x8 kf = *(const bf16x8*)(kimg + row * 128 + ((chunk ^ ((row >> 1) & 7)) << 4));
      s[kt] = MFMA32(kf, qf[ks], s[kt]);
    }
  }
  float mx = -1e30f;
#pragma unroll
  for (int kt = 0; kt < 2; ++kt)
#pragma unroll
    for (int i = 0; i < 16; ++i) {
      if (MASKED) {
        const int kk = kt * 32 + crow(i, h);
        const bool ok = (kk >= lo) && (kk <= hi);
        s[kt][i] = ok ? s[kt][i] : -1e30f;
      }
      mx = fmaxf(mx, s[kt][i]);
    }
  mx = fmaxf(mx, __shfl_xor(mx, 32));
  const float mn = fmaxf(m, mx);
  const float alpha = __builtin_amdgcn_exp2f(m - mn);
  m = mn;
  float ps = 0.f;
#pragma unroll
  for (int kt = 0; kt < 2; ++kt)
#pragma unroll
    for (int i = 0; i < 16; ++i) {
      const float pv = (!MASKED || s[kt][i] > -1e29f) ? __builtin_amdgcn_exp2f(s[kt][i] - mn) : 0.f;
      s[kt][i] = pv;
      ps += pv;
    }
  l = l * alpha + ps;
#pragma unroll
  for (int dt = 0; dt < 2; ++dt)
#pragma unroll
    for (int i = 0; i < 16; ++i) o[dt][i] *= alpha;
  const int i16 = lane & 15, q = i16 >> 2, pp = i16 & 3, blk = (lane >> 4) & 1;
#pragma unroll
  for (int kt = 0; kt < 2; ++kt)
#pragma unroll
    for (int st = 0; st < 2; ++st) {
      u32x4 pk = {pack2(s[kt][8 * st], s[kt][8 * st + 1]), pack2(s[kt][8 * st + 2], s[kt][8 * st + 3]),
                  pack2(s[kt][8 * st + 4], s[kt][8 * st + 5]), pack2(s[kt][8 * st + 6], s[kt][8 * st + 7])};
      const bf16x8 pf = __builtin_bit_cast(bf16x8, pk);
      const int row = kt * 32 + st * 16 + 4 * h + q;
#pragma unroll
      for (int dt = 0; dt < 2; ++dt) {
        const int cb = (dt * 32 + blk * 16 + pp * 4) * 2;
        const int a0 = row * 128 + (cb ^ (((row >> 1) & 1) << 6));
        const s16x4 lo4 = __builtin_amdgcn_ds_read_tr16_b64_v4i16((s16x4 __attribute__((address_space(3)))*)(vimg + a0));
        const s16x4 hi4 = __builtin_amdgcn_ds_read_tr16_b64_v4i16((s16x4 __attribute__((address_space(3)))*)(vimg + a0 + 8 * 128));
        const bf16x8 vf = __builtin_shufflevector(lo4, hi4, 0, 1, 2, 3, 4, 5, 6, 7);
        o[dt] = MFMA32(vf, pf, o[dt]);
      }
    }
}
DI void attn_store(const f32x16 (&o)[2], float l, int lane, bool valid, bf16* dst, const bf16* gate) {
  const int h = lane >> 5;
  const float lt = l + __shfl_xor(l, 32);
  const float inv = 1.f / lt;
  if (valid) {
#pragma unroll
    for (int dt = 0; dt < 2; ++dt)
#pragma unroll
      for (int g4 = 0; g4 < 4; ++g4) {
        const int d0 = dt * 32 + g4 * 8 + 4 * h;
        const u32x2 gg = *(const u32x2*)(gate + d0);
        u32x2 ov = {pack2(o[dt][4 * g4] * inv * bflo(gg[0]), o[dt][4 * g4 + 1] * inv * bfhi(gg[0])),
                    pack2(o[dt][4 * g4 + 2] * inv * bflo(gg[1]), o[dt][4 * g4 + 3] * inv * bfhi(gg[1]))};
        *(u32x2*)(dst + d0) = ov;
      }
  }
}
DI void attn_store_rows(const f32x16 (&o)[2], float l, int lane, char* slab, bf16* dst0, const bf16* gate0, int ldg) {
  const int r = lane & 31, h = lane >> 5;
  const float lt = l + __shfl_xor(l, 32);
  const float inv = 1.f / lt;
#pragma unroll
  for (int dt = 0; dt < 2; ++dt)
#pragma unroll
    for (int g4 = 0; g4 < 4; ++g4) {
      const int d0 = dt * 32 + g4 * 8 + 4 * h;
      u32x2 ov = {pack2(o[dt][4 * g4] * inv, o[dt][4 * g4 + 1] * inv), pack2(o[dt][4 * g4 + 2] * inv, o[dt][4 * g4 + 3] * inv)};
      *(u32x2*)(slab + r * 144 + d0 * 2) = ov;
    }
  asm volatile("s_waitcnt lgkmcnt(0)" ::: "memory");
#pragma unroll
  for (int i = 0; i < 4; ++i) {
    const int row = i * 8 + (lane >> 3), c8 = lane & 7;
    const u32x4 t = *(const u32x4*)(slab + row * 144 + c8 * 16);
    const u32x4 g = *(const u32x4*)(gate0 + (size_t)row * ldg + c8 * 8);
    u32x4 ov;
#pragma unroll
    for (int e = 0; e < 4; ++e) ov[e] = pack2(bflo(t[e]) * bflo(g[e]), bfhi(t[e]) * bfhi(g[e]));
    *(u32x4*)(dst0 + (size_t)row * 1024 + c8 * 8) = ov;
  }
  asm volatile("s_waitcnt lgkmcnt(0)" ::: "memory");
}
DI void load_q(bf16x8 (&qf)[4], const bf16* qrow, int h) {
#pragma unroll
  for (int ks = 0; ks < 4; ++ks) qf[ks] = *(const bf16x8*)(qrow + ks * 16 + 8 * h);
}
template <int NROWS>
DI void stage_bf16(char* img, const bf16* src, int ld, bool vimg, int zero_below) {
  const int tid = threadIdx.x;
#pragma unroll
  for (int i = 0; i < NROWS / 64; ++i) {
    const int id = tid + 512 * i, row = id >> 3, kc = id & 7;
    u32x4 t = {0u, 0u, 0u, 0u};
    if (row >= zero_below) t = *(const u32x4*)(src + (ptrdiff_t)row * ld + kc * 8);
    const int sw = vimg ? (kc ^ (((row >> 1) & 1) << 2)) : (kc ^ ((row >> 1) & 7));
    *(u32x4*)(img + row * 128 + (sw << 4)) = t;
  }
}

DI void mem_attn_prompt(const Params& p, int layer, int unit, char* smem) {
  const int tt = unit >> 2, hh = unit & 3;
  const int lane = threadIdx.x & 63, w = threadIdx.x >> 6, r = lane & 31, h = lane >> 5;
  const int ldz = layer ? 2560 : 2048, qcol = layer ? 2048 : 1536, gcol = layer ? 2304 : 1792;
  char* kimg = smem; char* vimg = smem + 32768;
  stage_bf16<256>(kimg, p.mkb + (size_t)layer * 65536 + hh * 64, 256, false, 0);
  stage_bf16<256>(vimg, p.mkb + 131072 + (size_t)layer * 65536 + hh * 64, 256, true, 0);
  const int tok = tt * 256 + w * 32 + r;
  bf16x8 qf[4];
  load_q(qf, p.z + (size_t)tok * ldz + qcol + hh * 64, h);
  __syncthreads();
  float m = -1e30f, l = 0.f;
  f32x16 o[2];
#pragma unroll
  for (int dt = 0; dt < 2; ++dt)
#pragma unroll
    for (int i = 0; i < 16; ++i) o[dt][i] = 0.f;
#pragma unroll 1
  for (int c = 0; c < 4; ++c) attn_chunk<false>(qf, kimg + c * 8192, vimg + c * 8192, m, l, o, lane, 0, 63);
  {
    const int tok0 = tt * 256 + w * 32;
    attn_store_rows(o, l, lane, smem + 98304 + w * 4608, p.act + (size_t)tok0 * 1024 + 768 + hh * 64, p.z + (size_t)tok0 * ldz + gcol + hh * 64, ldz);
  }
  __syncthreads();
}
DI void swa_prompt(const Params& p, int unit, char* smem) {
  const int n = unit >> 2, kvh = unit & 3;
  const int lane = threadIdx.x & 63, w = threadIdx.x >> 6, r = lane & 31, h = lane >> 5;
  char* kimg = smem; char* vimg = smem + 49152;
  const bf16* kv0 = p.z + (ptrdiff_t)(n * 256 - 128) * 2560 + kvh * 64;
  const int zb = n == 0 ? 128 : 0;
  stage_bf16<384>(kimg, kv0, 2560, false, zb);
  stage_bf16<384>(vimg, kv0 + 256, 2560, true, zb);
  __syncthreads();
  const int t = w * 32 + r, tok = n * 256 + t;
  const int klo = (n == 0 && t + 1 < 128) ? 128 : t + 1, khi = t + 128;
  const int c0 = (32 * w + 1) >> 6, c1 = (32 * w + 159) >> 6;
#pragma unroll 1
  for (int g = 0; g < 3; ++g) {
    const int head = kvh * 3 + g;
    bf16x8 qf[4];
    load_q(qf, p.z + (size_t)tok * 2560 + 512 + head * 64, h);
    float m = p.sinks[head] * LOG2E, l = h == 0 ? 1.f : 0.f;
    f32x16 o[2];
#pragma unroll
    for (int dt = 0; dt < 2; ++dt)
#pragma unroll
      for (int i = 0; i < 16; ++i) o[dt][i] = 0.f;
#pragma unroll 1
    for (int c = c0; c <= c1; ++c) attn_chunk<true>(qf, kimg + c * 8192, vimg + c * 8192, m, l, o, lane, klo - 64 * c, khi - 64 * c);
    attn_store_rows(o, l, lane, smem + 98304 + w * 4608, p.act + (size_t)(n * 256 + w * 32) * 1024 + head * 64, p.z + (size_t)(n * 256 + w * 32) * 2560 + 1280 + head * 64, 2560);
  }
  __syncthreads();
}
template <bool SWA>
DI void stage_wave_kv(char* kimg, char* vimg, const float* ksrc, const float* vsrc, int key0, int nvalid, const bf16* extra, int nextra, int head,
                      float* kcopy, float* vcopy, int lane) {
  f32x4 ka[8], kb[8], va[8], vb[8];
#pragma unroll
  for (int i = 0; i < 8; ++i) {
    const int id = lane + 64 * i, key = id >> 3, kc = id & 7, kk = key0 + key;
    ka[i] = kb[i] = va[i] = vb[i] = (f32x4){0.f, 0.f, 0.f, 0.f};
    if (kk < nvalid) {
      const size_t o = (size_t)kk * 256 + head * 64 + kc * 8;
      ka[i] = *(const f32x4*)(ksrc + o); kb[i] = *(const f32x4*)(ksrc + o + 4);
      va[i] = *(const f32x4*)(vsrc + o); vb[i] = *(const f32x4*)(vsrc + o + 4);
    } else if (SWA && kk - nvalid < nextra) {
      const bf16* e = extra + (size_t)(kk - nvalid) * 2560 + head * 64 + kc * 8;
      ka[i] = __builtin_bit_cast(f32x4, *(const u32x4*)e); va[i] = __builtin_bit_cast(f32x4, *(const u32x4*)(e + 256));
    }
  }
#pragma unroll
  for (int i = 0; i < 8; ++i) {
    const int id = lane + 64 * i, key = id >> 3, kc = id & 7, kk = key0 + key;
    u32x4 tk = __builtin_bit_cast(u32x4, ka[i]), tv = __builtin_bit_cast(u32x4, va[i]);
    if (kk < nvalid) {
      if (SWA && kk >= 8) {
        const size_t o = (size_t)(kk - 8) * 256 + head * 64 + kc * 8;
        *(f32x4*)(kcopy + o) = ka[i]; *(f32x4*)(kcopy + o + 4) = kb[i];
        *(f32x4*)(vcopy + o) = va[i]; *(f32x4*)(vcopy + o + 4) = vb[i];
      }
      tk = (u32x4){pack2(ka[i][0], ka[i][1]), pack2(ka[i][2], ka[i][3]), pack2(kb[i][0], kb[i][1]), pack2(kb[i][2], kb[i][3])};
      tv = (u32x4){pack2(va[i][0], va[i][1]), pack2(va[i][2], va[i][3]), pack2(vb[i][0], vb[i][1]), pack2(vb[i][2], vb[i][3])};
    }
    *(u32x4*)(kimg + key * 128 + ((kc ^ ((key >> 1) & 7)) << 4)) = tk;
    *(u32x4*)(vimg + key * 128 + ((kc ^ (((key >> 1) & 1) << 2)) << 4)) = tv;
  }
}
template <bool SWA>
DI void decode_unit(const Params& p, int layer, int unit, char* smem) {
  const int tid = threadIdx.x, lane = tid & 63, w = tid >> 6, r = lane & 31, h = lane >> 5;
  const int b = unit >> 1, hd = (unit & 1) * 2 + (w >> 2), c = w & 3;
  const int ldz = (SWA || layer) ? 2560 : 2048;
  char* kimg = smem + w * 16384; char* vimg = kimg + 8192;
  const int t = r & 7, g = SWA ? ((r >> 3) > 2 ? 2 : (r >> 3)) : 0;
  const int qhead = SWA ? hd * 3 + g : hd;
  const int qcol = SWA ? 512 : (layer ? 2048 : 1536);
  const int tok = NPR + b * 8 + t;
  bf16x8 qf[4];
  load_q(qf, p.z + (size_t)tok * ldz + qcol + qhead * 64, h);
  const bool active = SWA ? (c < 3) : true;
  if (active) {
    if (SWA) {
      const bf16* knew = p.z + (size_t)(NPR + b * 8) * 2560;
      stage_wave_kv<true>(kimg, vimg, p.cswk + (size_t)b * 32768, p.cswv + (size_t)b * 32768, c * 64, 128, knew, 8, hd,
                          p.out + O_SKS + (size_t)b * 32768, p.out + O_SVS + (size_t)b * 32768, lane);
    } else {
      stage_wave_kv<false>(kimg, vimg, p.cmk + ((size_t)layer * 128 + b) * 65536, p.cmv + ((size_t)layer * 128 + b) * 65536, c * 64, 256, nullptr, 0, hd,
                           nullptr, nullptr, lane);
    }
  }
  __syncthreads();
  float m = -1e30f, l = 0.f;
  if (SWA && c == 0) { m = p.sinks[qhead] * LOG2E; l = h == 0 ? 1.f : 0.f; }
  f32x16 o[2];
#pragma unroll
  for (int dt = 0; dt < 2; ++dt)
#pragma unroll
    for (int i = 0; i < 16; ++i) o[dt][i] = 0.f;
  if (active) attn_chunk<SWA>(qf, kimg, vimg, m, l, o, lane, SWA ? t + 1 - 64 * c : 0, SWA ? t + 128 - 64 * c : 63);
  __syncthreads();
  float* R = (float*)(smem + w * 16384);
  const float lt = l + __shfl_xor(l, 32);
#pragma unroll
  for (int dt = 0; dt < 2; ++dt)
#pragma unroll
    for (int i = 0; i < 16; ++i) R[(dt * 32 + crow(i, h)) * 32 + r] = o[dt][i];
  if (h == 0) { R[2048 + r] = m; R[2080 + r] = lt; }
  __syncthreads();
  const int head2 = tid >> 8, slot = (tid & 255) >> 3, dg = tid & 7;
  if (slot < (SWA ? 24 : 8)) {
    float mc[4], lc[4], M = -1e30f;
#pragma unroll
    for (int cc = 0; cc < 4; ++cc) {
      const float* Rc = (const float*)(smem + (head2 * 4 + cc) * 16384);
      mc[cc] = Rc[2048 + slot]; lc[cc] = Rc[2080 + slot];
      M = fmaxf(M, mc[cc]);
    }
    float L = 0.f, a8[8];
#pragma unroll
    for (int e = 0; e < 8; ++e) a8[e] = 0.f;
#pragma unroll
    for (int cc = 0; cc < 4; ++cc) {
      const float* Rc = (const float*)(smem + (head2 * 4 + cc) * 16384);
      const float wgt = __builtin_amdgcn_exp2f(mc[cc] - M);
      L += wgt * lc[cc];
#pragma unroll
      for (int e = 0; e < 8; ++e) a8[e] += wgt * Rc[(dg * 8 + e) * 32 + slot];
    }
    const float inv = 1.f / L;
    const int hd2 = (unit & 1) * 2 + head2, t2 = slot & 7, g2 = slot >> 3;
    const int tok2 = NPR + b * 8 + t2;
    const int ocol = SWA ? (hd2 * 3 + g2) * 64 : 768 + hd2 * 64;
    const int gcol = SWA ? 1280 + (hd2 * 3 + g2) * 64 : (layer ? 2304 : 1792) + hd2 * 64;
    const u32x4 gg = *(const u32x4*)(p.z + (size_t)tok2 * ldz + gcol + dg * 8);
    u32x4 ov;
#pragma unroll
    for (int e = 0; e < 4; ++e) ov[e] = pack2(a8[2 * e] * inv * bflo(gg[e]), a8[2 * e + 1] * inv * bfhi(gg[e]));
    *(u32x4*)(p.act + (size_t)tok2 * 1024 + ocol + dg * 8) = ov;
  }
  __syncthreads();
}
template <int W>
DI void pool_d_item(const Params& p, int tok, int c0, bf16* __restrict__ dbuf) {
  const bf16* __restrict__ zz = p.z;
  float a[8];
#pragma unroll
  for (int j = 0; j < 8; ++j) a[j] = 0.f;
  u32x4 u0 = {0u, 0u, 0u, 0u};
  float cnt;
  if (tok < NPR) {
    const int nr = tok + 1 < W ? tok + 1 : W;
    cnt = (float)nr;
    u32x4 t[W];
#pragma unroll
    for (int j = 0; j < W; ++j) { const int rr = tok - j < 0 ? 0 : tok - j; t[j] = *(const u32x4*)(zz + (size_t)rr * 2048 + c0); }
    u0 = t[0];
#pragma unroll
    for (int j = 0; j < W; ++j) {
      const float vm = j < nr ? 1.f : 0.f;
#pragma unroll
      for (int e = 0; e < 4; ++e) { a[2 * e] += vm * bflo(t[j][e]); a[2 * e + 1] += vm * bfhi(t[j][e]); }
    }
  } else {
    const int s = tok - NPR, b = s >> 3, t8 = s & 7;
    cnt = (float)W;
    u0 = *(const u32x4*)(zz + (size_t)tok * 2048 + c0);
#pragma unroll
    for (int j = 0; j < W; ++j) {
      const int tt = t8 - j;
      if (tt >= 0) {
        const u32x4 t = *(const u32x4*)(zz + (size_t)(tok - j) * 2048 + c0);
#pragma unroll
        for (int e = 0; e < 4; ++e) { a[2 * e] += bflo(t[e]); a[2 * e + 1] += bfhi(t[e]); }
      } else {
        const float* sp = p.state_pool + (size_t)(b * 15 + 15 + tt) * 768 + c0;
        const f32x4 x0 = *(const f32x4*)sp, x1 = *(const f32x4*)(sp + 4);
        a[0] += x0[0]; a[1] += x0[1]; a[2] += x0[2]; a[3] += x0[3]; a[4] += x1[0]; a[5] += x1[1]; a[6] += x1[2]; a[7] += x1[3];
      }
    }
  }
  const float ic = 1.f / cnt;
  u32x4 o;
#pragma unroll
  for (int e = 0; e < 4; ++e) o[e] = pack2(a[2 * e] * ic - bflo(u0[e]), a[2 * e + 1] * ic - bfhi(u0[e]));
  *(u32x4*)(dbuf + (size_t)tok * 768 + c0) = o;
}

DI void transpose_tile(const float* src, int K, int N, const float* gain, bf16* dst, int tile, char* smem, bool valid) {
  const int tid = threadIdx.x & 255;
  float* T = (float*)(smem + (threadIdx.x >> 8) * 16640);
  const int ntn = N >> 6, k0 = (tile / ntn) << 6, n0 = (tile % ntn) << 6;
  const int c4 = tid & 15, ri = tid >> 4;
  if (valid) {
#pragma unroll
    for (int i = 0; i < 4; ++i) {
      const int k = ri + 16 * i;
      f32x4 t = *(const f32x4*)(src + (size_t)(k0 + k) * N + n0 + c4 * 4);
      const float gsc = gain ? gain[k0 + k] : 1.f;
      T[k * 65 + c4 * 4] = t[0] * gsc; T[k * 65 + c4 * 4 + 1] = t[1] * gsc; T[k * 65 + c4 * 4 + 2] = t[2] * gsc; T[k * 65 + c4 * 4 + 3] = t[3] * gsc;
    }
  }
  __syncthreads();
  const int k8 = tid & 7, nn = tid >> 3;
  if (valid) {
#pragma unroll
    for (int i = 0; i < 2; ++i) {
      const int n = nn + 32 * i;
      const float* tp = T + (k8 * 8) * 65 + n;
      u32x4 o = {pack2(tp[0], tp[65]), pack2(tp[130], tp[195]), pack2(tp[260], tp[325]), pack2(tp[390], tp[455])};
      *(u32x4*)(dst + (size_t)(n0 + n) * K + k0 + k8 * 8) = o;
    }
  }
  __syncthreads();
}
DI void row_prep(const float* src, bf16* dst, float* rstd, int lane) {
  float ss = 0.f;
  f32x4 t[4];
#pragma unroll
  for (int i = 0; i < 4; ++i) { t[i] = *(const f32x4*)(src + i * 256 + lane * 4); ss += t[i][0] * t[i][0] + t[i][1] * t[i][1] + t[i][2] * t[i][2] + t[i][3] * t[i][3]; }
#pragma unroll
  for (int o = 32; o > 0; o >>= 1) ss += __shfl_xor(ss, o);
#pragma unroll
  for (int i = 0; i < 4; ++i) { u32x2 ov = {pack2(t[i][0], t[i][1]), pack2(t[i][2], t[i][3])}; *(u32x2*)(dst + i * 256 + lane * 4) = ov; }
  if (lane == 0) *rstd = rsqrtf(ss * (1.f / 1024.f) + EPS);
}

#define XB_TMO      128
#define XB_XCNT(j)  (256  + 64 * (j))
#define XB_XSUB(j)  (1280 + 64 * (j))
#define XB_XGEN(j)  (2304 + 64 * (j))
#define XB_TOP      3328
#define XB_TOPGEN   3392
#define XCD_BAR_WORDS 3456
#define XB_SPIN_CAP (1u << 18)
#define LAS __attribute__((address_space(3)))
DI unsigned xb_ld(unsigned* p) { return __hip_atomic_load(p, __ATOMIC_RELAXED, __HIP_MEMORY_SCOPE_AGENT); }
DI unsigned xb_add(unsigned* p, unsigned v) { return __hip_atomic_fetch_add(p, v, __ATOMIC_RELAXED, __HIP_MEMORY_SCOPE_AGENT); }
DI unsigned xb_xcc_id() { return (unsigned)__builtin_amdgcn_s_getreg((3 << 11) | 20) & 0xFu; }
#define XB_SPIN(cond, bar) do { unsigned _sp = 0; while (cond) { __builtin_amdgcn_s_sleep(1); \
    if ((++_sp & 255u) == 0u) { if (xb_ld(&(bar)[XB_TMO])) break; if (_sp > XB_SPIN_CAP) { atomicAdd(&(bar)[XB_TMO], 1u); break; } } } } while (0)
struct XcdBarrier { unsigned* bar; unsigned x; volatile LAS unsigned* st; };
DI XcdBarrier xcd_barrier_post(unsigned* bar, volatile LAS unsigned* st) {
  XcdBarrier b; b.bar = bar; b.x = xb_xcc_id(); b.st = st;
  if (threadIdx.x == 0) st[2] = xb_add(&bar[XB_XCNT(b.x)], 1u);
  return b;
}
DI void xcd_barrier_complete(unsigned* bar, unsigned x, unsigned& nloc, unsigned& nx) {
  const unsigned G = gridDim.x * gridDim.y * gridDim.z;
  unsigned sum, cnt, mine, sp = 0u;
  for (;;) {
    sum = 0u; cnt = 0u; mine = 0u;
#pragma unroll
    for (unsigned j = 0; j < 16; ++j) { const unsigned c = xb_ld(&bar[XB_XCNT(j)]); sum += c; cnt += (c > 0u) ? 1u : 0u; mine = (j == x) ? c : mine; }
    if (sum == G) break;
    __builtin_amdgcn_s_sleep(1);
    if ((++sp & 255u) == 0u) { if (xb_ld(&bar[XB_TMO])) break; if (sp > XB_SPIN_CAP) { atomicAdd(&bar[XB_TMO], 1u); break; } }
  }
  nloc = mine > 0u ? mine : 1u; nx = cnt > 0u ? cnt : 1u;
}
DI void xcd_barrier(const XcdBarrier& b) {
  asm volatile("s_waitcnt vmcnt(0)" ::: "memory");
  __syncthreads();
  if (threadIdx.x == 0) {
    unsigned* bar = b.bar;
    __builtin_amdgcn_s_waitcnt(0);
    unsigned nloc = b.st[0], nx = b.st[1];
    if (nloc == 0u) { xcd_barrier_complete(bar, b.x, nloc, nx); b.st[0] = nloc; b.st[1] = nx; }
    const unsigned old = xb_add(&bar[XB_XSUB(b.x)], 1u);
    const unsigned gen = old / nloc;
    if (old + 1u == (gen + 1u) * nloc) {
      __builtin_amdgcn_fence(__ATOMIC_RELEASE, "agent");
      asm volatile("s_waitcnt vmcnt(0)" ::: "memory");
      const unsigned og = xb_add(&bar[XB_TOP], 1u);
      const unsigned tg = og / nx;
      if (og + 1u == (tg + 1u) * nx) xb_add(&bar[XB_TOPGEN], 1u);
      else XB_SPIN(xb_ld(&bar[XB_TOPGEN]) == tg, bar);
      __builtin_amdgcn_fence(__ATOMIC_ACQUIRE, "agent");
      xb_add(&bar[XB_XGEN(b.x)], 1u);
      asm volatile("s_waitcnt vmcnt(0)" ::: "memory");
    } else {
      XB_SPIN(xb_ld(&bar[XB_XGEN(b.x)]) == gen, bar);
      __builtin_amdgcn_fence(__ATOMIC_ACQUIRE, "agent");
      asm volatile("s_waitcnt vmcnt(0)" ::: "memory");
    }
  }
  __syncthreads();
}

template <int PH>
DI void run_phase(const Params& p, char* smem, int vbid) {
  const int bid = blockIdx.x, nb = gridDim.x, tid = threadIdx.x, NT = 512;
  if constexpr (PH == 0) {
    {
      const int lane = tid & 63, w = tid >> 6;
#pragma unroll 1
      for (int u = bid; u < (NTOK + 256) / 16; u += nb) {
        const int row0 = u * 16 + w * 2;
        f32x4 t[2][4];
        const float* src[2]; bf16* dst[2]; float* rs[2];
#pragma unroll
        for (int q = 0; q < 2; ++q) {
          const int row = row0 + q;
          if (row < NTOK) { src[q] = xrow(p, row); dst[q] = p.xb + (size_t)row * 1024; rs[q] = p.rstd_a + row; }
          else { src[q] = p.memp + (size_t)(row - NTOK) * 1024; dst[q] = p.memb + (size_t)(row - NTOK) * 1024; rs[q] = p.rstd_mem + (row - NTOK); }
#pragma unroll
          for (int i = 0; i < 4; ++i) t[q][i] = *(const f32x4*)(src[q] + i * 256 + lane * 4);
        }
#pragma unroll
        for (int q = 0; q < 2; ++q) {
          float ss = 0.f;
#pragma unroll
          for (int i = 0; i < 4; ++i) ss += t[q][i][0] * t[q][i][0] + t[q][i][1] * t[q][i][1] + t[q][i][2] * t[q][i][2] + t[q][i][3] * t[q][i][3];
#pragma unroll
          for (int o = 32; o > 0; o >>= 1) ss += __shfl_xor(ss, o);
#pragma unroll
          for (int i = 0; i < 4; ++i) { u32x2 ov = {pack2(t[q][i][0], t[q][i][1]), pack2(t[q][i][2], t[q][i][3])}; *(u32x2*)(dst[q] + i * 256 + lane * 4) = ov; }
          if (lane == 0) *rs[q] = rsqrtf(ss * (1.f / 1024.f) + EPS);
        }
      }
    }
#pragma unroll 1
    for (int u = bid; u < 978; u += nb) {
      int t = u * 2 + (tid >> 8);
      const float* src; const float* gain = nullptr; bf16* dst; int K = 1024, N = 1024;
      if (t < 512) { src = p.w_in_a; N = 2048; gain = p.norm_a; dst = p.Wt_in_a; }
      else if ((t -= 512) < 256) { src = p.w_out_a; dst = p.Wt_out_a; }
      else if ((t -= 256) < 128) { src = p.w_kv; N = 512; gain = p.kv_norm; dst = p.Wt_kvb; }
      else if ((t -= 128) < 512) { src = p.w_in_b; N = 2048; gain = p.norm_b; dst = p.Wt_kvb + 512 * 1024; }
      else if ((t -= 512) < 256) { src = p.w_out_b; dst = p.Wt_out_b; }
      else if ((t -= 256) < 256) { const int l = t >> 7; t &= 127; src = p.w_mem_kv + (size_t)l * 1024 * 512; N = 512; gain = p.mem_norm + l * 1024; dst = p.Wt_mem + (size_t)l * 512 * 1024; }
      else { t -= 256; const int g = t / 9; t %= 9; src = p.pool_mix_w + (size_t)g * 192 * 192; K = 192; N = 192; dst = p.Wt_pool + (size_t)g * 192 * 768 + g * 192; }
      if (K == 192) {
        const int ltid = tid & 255;
        float* T = (float*)(smem + (tid >> 8) * 16640);
        const int k0 = (t / 3) << 6, n0 = (t % 3) << 6, c4 = ltid & 15, ri = ltid >> 4;
#pragma unroll
        for (int i = 0; i < 4; ++i) {
          const int k = ri + 16 * i;
          f32x4 x = *(const f32x4*)(src + (size_t)(k0 + k) * 192 + n0 + c4 * 4);
          T[k * 65 + c4 * 4] = x[0]; T[k * 65 + c4 * 4 + 1] = x[1]; T[k * 65 + c4 * 4 + 2] = x[2]; T[k * 65 + c4 * 4 + 3] = x[3];
        }
      }
      if (K != 192) transpose_tile(src, K, N, gain, dst, t, smem, true);
      else {
        __syncthreads();
        const int ltid = tid & 255, k8 = ltid & 7, nn = ltid >> 3;
        const float* T = (const float*)(smem + (tid >> 8) * 16640);
        const int k0 = (t / 3) << 6, n0 = (t % 3) << 6;
#pragma unroll
        for (int i = 0; i < 2; ++i) {
          const int n = nn + 32 * i;
          const float* tp = T + (k8 * 8) * 65 + n;
          u32x4 o = {pack2(tp[0], tp[65]), pack2(tp[130], tp[195]), pack2(tp[260], tp[325]), pack2(tp[390], tp[455])};
          *(u32x4*)(dst + (size_t)(n0 + n) * 768 + k0 + k8 * 8) = o;
        }
        __syncthreads();
      }
    }
    for (int i = bid * NT + tid; i < 768 * 96; i += nb * NT) {
      const int n = i / 96, k8 = i % 96;
      if (n / 192 != k8 / 24) { u32x4 zz = {0u, 0u, 0u, 0u}; *(u32x4*)(p.Wt_pool + (size_t)n * 768 + k8 * 8) = zz; }
    }
    for (int i = bid * NT + tid; i < NTOK; i += nb * NT) p.ssq1[i] = 0.f;
    for (int i = bid * NT + tid; i < 128 * 7 * 192; i += nb * NT) {
      const int b = i / (7 * 192), rem = i % (7 * 192);
      *(f32x4*)(p.out + O_POOLS + (size_t)b * 15 * 768 + rem * 4) = *(const f32x4*)(p.state_pool + (size_t)b * 15 * 768 + 8 * 768 + rem * 4);
    }
  } else if constexpr (PH == 1) {
    gemm_phase(p.xb, 1024, p.Wt_in_a, 1024, 16, 68, 8, smem, EpiInA{p}, vbid);
#pragma unroll 1
    for (int v = nb - 1 - ((nb & 255) == 0 ? ((vbid & 31) * (nb >> 5) + (vbid >> 5)) : vbid); v < 16; v += nb) gemm_tile<128, 128>(p.memb, 1024, p.Wt_mem, 1024, 16, (v >> 3) * 128, (v & 7) * 128, smem, EpiMemKV{p});
  } else if constexpr (PH == 2) {
#pragma unroll 1
    for (int u = bid; u < 256; u += nb) mem_attn_prompt(p, 0, u, smem);
    {
      bf16* dbuf = p.dbuf;
      const int lane = tid & 63, gw = bid * 8 + (tid >> 6), nw = nb * 8;
#pragma unroll 1
      for (int it = gw; it < (NTOK / 8) * 4; it += nw) {
        const int tg = it >> 2, g = it & 3;
        const int tok = tg * 8 + (lane >> 3), c0 = g * 192 + (lane & 7) * 8;
        if (g == 0) { pool_d_item<2>(p, tok, c0, dbuf); pool_d_item<2>(p, tok, c0 + 64, dbuf); pool_d_item<2>(p, tok, c0 + 128, dbuf); }
        else if (g == 1) { pool_d_item<4>(p, tok, c0, dbuf); pool_d_item<4>(p, tok, c0 + 64, dbuf); pool_d_item<4>(p, tok, c0 + 128, dbuf); }
        else if (g == 2) { pool_d_item<8>(p, tok, c0, dbuf); pool_d_item<8>(p, tok, c0 + 64, dbuf); pool_d_item<8>(p, tok, c0 + 128, dbuf); }
        else { pool_d_item<16>(p, tok, c0, dbuf); pool_d_item<16>(p, tok, c0 + 64, dbuf); pool_d_item<16>(p, tok, c0 + 128, dbuf); }
      }
    }
  } else if constexpr (PH == 3) {
    const int vb = vbid, NG = 68 * 3;
    if (nb >= NG + 32) {
      if (vb < NG) {
        const int mt = vb / 3, nt = vb % 3;
        gemm_tile<256, 256>(p.dbuf + nt * 192, 768, p.Wt_pool + nt * 192, 768, 6, mt * 256, nt * 256, smem, EpiPool{p});
      } else {
#pragma unroll 1
        for (int u = vb - NG; u < 256; u += nb - NG) decode_unit<false>(p, 0, u, smem);
      }
    } else {
#pragma unroll 1
      for (int u = vb; u < NG; u += nb) {
        const int mt = u / 3, nt = u % 3;
        gemm_tile<256, 256>(p.dbuf + nt * 192, 768, p.Wt_pool + nt * 192, 768, 6, mt * 256, nt * 256, smem, EpiPool{p});
      }
#pragma unroll 1
      for (int u = bid; u < 256; u += nb) decode_unit<false>(p, 0, u, smem);
    }
  } else if constexpr (PH == 4) {
    gemm_phase(p.act, 1024, p.Wt_out_a, 1024, 16, 68, 4, smem, EpiOutA{p}, vbid);
  } else if constexpr (PH == 5) {
    gemm_phase(p.xb, 1024, p.Wt_kvb, 1024, 16, 68, 10, smem, EpiKVB{p}, vbid);
  } else if constexpr (PH == 6) {
#pragma unroll 1
    for (int u = bid; u < 256; u += nb) swa_prompt(p, u, smem);
#pragma unroll 1
    for (int u = bid; u < 256; u += nb) mem_attn_prompt(p, 1, u, smem);
#pragma unroll 1
    for (int u = bid; u < 256; u += nb) decode_unit<true>(p, 1, u, smem);
#pragma unroll 1
    for (int u = bid; u < 256; u += nb) decode_unit<false>(p, 1, u, smem);
  } else if constexpr (PH == 7) {
    gemm_phase(p.act, 1024, p.Wt_out_b, 1024, 16, 68, 4, smem, EpiOutB{p}, vbid);
  }
}

#if MULTI_LAUNCH
template <int PH>
__global__ void __launch_bounds__(512) phase_kernel(Params p) {
  __shared__ __attribute__((aligned(1024))) char smem[135168];
  run_phase<PH>(p, smem, blockIdx.x);
}
#else
__global__ void __launch_bounds__(512) yoco_megakernel(Params p) {
  __shared__ __attribute__((aligned(1024))) char smem[135168];
  __shared__ uint4 xb_words;
  if (threadIdx.x == 0) xb_words = make_uint4(0u, 0u, 0u, 0u);
  __syncthreads();
  XcdBarrier xb = xcd_barrier_post(p.bar, (volatile LAS unsigned*)&xb_words);
  run_phase<0>(p, smem, blockIdx.x); xcd_barrier(xb);
  if (threadIdx.x == 0) {
    const unsigned per = gridDim.x >> 3;
    bool even = (gridDim.x & 7u) == 0u;
    for (unsigned j = 0; j < 16; ++j) { const unsigned c = xb_ld(&p.bar[XB_XCNT(j)]); even = even && (j < 8 ? c == per : c == 0u); }
    const unsigned rank = ((volatile LAS unsigned*)&xb_words)[2];
    ((volatile LAS unsigned*)&xb_words)[3] = even ? xb.x * per + rank : blockIdx.x;
  }
  __syncthreads();
  const int vbid = (int)((volatile LAS unsigned*)&xb_words)[3];
  run_phase<1>(p, smem, vbid); xcd_barrier(xb);
  run_phase<2>(p, smem, vbid); xcd_barrier(xb);
  run_phase<3>(p, smem, vbid); xcd_barrier(xb);
  run_phase<4>(p, smem, vbid); xcd_barrier(xb);
  run_phase<5>(p, smem, vbid); xcd_barrier(xb);
  run_phase<6>(p, smem, vbid); xcd_barrier(xb);
  run_phase<7>(p, smem, vbid);
}
#endif

extern "C" void kernel_launch(void* const* d_in, const int* in_sizes, int n_in, void* d_out, int out_size, void* d_ws, size_t ws_size, hipStream_t stream) {
  Params p{};
  const float* const* in = (const float* const*)d_in;
  p.xp = in[0]; p.xs = in[1]; p.state_pool = in[2]; p.cswk = in[3]; p.cswv = in[4]; p.cmk = in[5]; p.cmv = in[6]; p.memp = in[7];
  p.norm_a = in[8]; p.w_in_a = in[9]; p.pool_mix_w = in[10]; p.pool_scale = in[11]; p.w_out_a = in[12]; p.kv_norm = in[13]; p.w_kv = in[14];
  p.k_norm = in[15]; p.norm_b = in[16]; p.w_in_b = in[17]; p.q_norm = in[18]; p.sinks = in[19]; p.w_out_b = in[20]; p.mem_norm = in[21];
  p.w_mem_kv = in[22]; p.mem_q_norm = in[23]; p.mem_k_norm = in[24];
  p.out = (float*)d_out;
  char* ws = (char*)d_ws;
  size_t off = 0;
  auto take = [&](size_t bytes) { char* r = ws + off; off += (bytes + 255) & ~(size_t)255; return r; };
  p.Wt_in_a = (bf16*)take((size_t)2048 * 1024 * 2);
  p.Wt_out_a = (bf16*)take((size_t)1024 * 1024 * 2);
  p.Wt_kvb = (bf16*)take((size_t)2560 * 1024 * 2);
  p.Wt_out_b = (bf16*)take((size_t)1024 * 1024 * 2);
  p.Wt_mem = (bf16*)take((size_t)1024 * 1024 * 2);
  p.Wt_pool = (bf16*)take((size_t)768 * 768 * 2);
  p.memb = (bf16*)take((size_t)256 * 1024 * 2);
  p.mkb = (bf16*)take((size_t)4 * 256 * 256 * 2);
  p.rstd_a = (float*)take((size_t)NTOK * 4);
  p.rstd_mem = (float*)take(256 * 4);
  p.ssq1 = (float*)take((size_t)NTOK * 4);
  p.bar = (unsigned*)take((size_t)XCD_BAR_WORDS * 4);
  p.xb = (bf16*)take((size_t)NTOK * 1024 * 2);
  p.act = (bf16*)take((size_t)NTOK * 1024 * 2);
  p.dbuf = (bf16*)take((size_t)NTOK * 768 * 2);
  p.z = (bf16*)take((size_t)NTOK * 2560 * 2);
  for (int i = 0; i < 8; ++i) p.rope_inv[i] = powf(500000.0f, -(float)i / 8.0f);
#if MULTI_LAUNCH
  const int grid = 256;
  phase_kernel<0><<<grid, 512, 0, stream>>>(p);
  phase_kernel<1><<<grid, 512, 0, stream>>>(p);
  phase_kernel<2><<<grid, 512, 0, stream>>>(p);
  phase_kernel<3><<<grid, 512, 0, stream>>>(p);
  phase_kernel<4><<<grid, 512, 0, stream>>>(p);
  phase_kernel<5><<<grid, 512, 0, stream>>>(p);
  phase_kernel<6><<<grid, 512, 0, stream>>>(p);
  phase_kernel<7><<<grid, 512, 0, stream>>>(p);
#else
  static int grid_blocks = 0;
  if (!grid_blocks) {
    int dev = 0, cus = 0, per_cu = 0;
    hipGetDevice(&dev);
    hipDeviceGetAttribute(&cus, hipDeviceAttributeMultiprocessorCount, dev);
    (void)hipOccupancyMaxActiveBlocksPerMultiprocessor(&per_cu, yoco_megakernel, 512, 0);
    if (per_cu > 1) per_cu = 1;
    grid_blocks = cus * per_cu;
  }
  (void)hipMemsetAsync(p.bar, 0, (size_t)XCD_BAR_WORDS * 4, stream);
  void* args[] = {&p};
  hipError_t e = hipLaunchCooperativeKernel((void*)yoco_megakernel, dim3(grid_blocks), dim3(512), args, 0, stream);
  if (e != hipSuccess) fprintf(stderr, "cooperative launch failed: %s (grid %d)\n", hipGetErrorString(e), grid_blocks);
#endif
}
```

```cpp
#include <hip/hip_runtime.h>
#include <hip/hip_cooperative_groups.h>
#include <cstdio>
#include <cmath>
namespace cg = cooperative_groups;

#ifndef MULTI_LAUNCH
#define MULTI_LAUNCH 0
#endif

typedef unsigned short bf16;
typedef short bf16x8 __attribute__((ext_vector_type(8)));
typedef short s16x4 __attribute__((ext_vector_type(4)));
typedef float f32x16 __attribute__((ext_vector_type(16)));
typedef float f32x4 __attribute__((ext_vector_type(4)));
typedef unsigned u32x4 __attribute__((ext_vector_type(4)));
typedef unsigned u32x2 __attribute__((ext_vector_type(2)));
#define DI __device__ __forceinline__
#define MFMA32(a, b, c) __builtin_amdgcn_mfma_f32_32x32x16_bf16((a), (b), (c), 0, 0, 0)

constexpr int NTOK = 17408, NPR = 16384, DM = 1024;
constexpr float EPS = 1e-6f;
constexpr float LOG2E = 1.4426950408889634f;
constexpr size_t O_Y = 0, O_POOLP = 17825792, O_POOLS = 17837312, O_SKP = 19311872, O_SVP = 19344640,
                 O_SKS = 19377408, O_SVS = 23571712, O_MKP = 27766016, O_MVP = 27897088;

struct Params {
  const float *xp, *xs, *state_pool, *cswk, *cswv, *cmk, *cmv, *memp;
  const float *norm_a, *w_in_a, *pool_mix_w, *pool_scale, *w_out_a, *kv_norm, *w_kv, *k_norm, *norm_b, *w_in_b, *q_norm,
      *sinks, *w_out_b, *mem_norm, *w_mem_kv, *mem_q_norm, *mem_k_norm;
  float* out;
  bf16 *Wt_in_a, *Wt_out_a, *Wt_kvb, *Wt_out_b, *Wt_mem, *Wt_pool;
  bf16 *xb, *act, *z, *memb, *mkb, *dbuf;
  float *rstd_a, *rstd_mem, *ssq1;
  unsigned* bar;
  float rope_inv[8];
};

DI unsigned pack2(float a, float b) {
  typedef __bf16 bf2 __attribute__((ext_vector_type(2)));
  typedef float f2 __attribute__((ext_vector_type(2)));
  f2 f = {a, b};
  return __builtin_bit_cast(unsigned, __builtin_convertvector(f, bf2));
}
DI float bflo(unsigned u) { return __uint_as_float(u << 16); }
DI float bfhi(unsigned u) { return __uint_as_float(u & 0xffff0000u); }
DI float silu(float x) { return x * __builtin_amdgcn_rcpf(1.f + __builtin_amdgcn_exp2f(-LOG2E * x)); }
DI int crow(int i, int h) { return (i & 3) + 8 * (i >> 2) + 4 * h; }
DI const float* xrow(const Params& p, int tok) { return tok < NPR ? p.xp + (size_t)tok * DM : p.xs + (size_t)(tok - NPR) * DM; }

template <int MI, int NI>
DI void frag_read(u32x4 (&fa)[MI], u32x4 (&fb)[NI], unsigned ab, unsigned bb) {
  if constexpr (MI == 4 && NI == 2) {
    asm volatile("ds_read_b128 %0, %6\n\tds_read_b128 %1, %6 offset:2048\n\tds_read_b128 %2, %6 offset:4096\n\tds_read_b128 %3, %6 offset:6144\n\t"
                 "ds_read_b128 %4, %7\n\tds_read_b128 %5, %7 offset:2048"
                 : "=&v"(fa[0]), "=&v"(fa[1]), "=&v"(fa[2]), "=&v"(fa[3]), "=&v"(fb[0]), "=&v"(fb[1]) : "v"(ab), "v"(bb) : "memory");
  } else {
    static_assert((MI == 4 && NI == 2) || (MI == 2 && NI == 1), "tile config");
    asm volatile("ds_read_b128 %0, %3\n\tds_read_b128 %1, %3 offset:2048\n\tds_read_b128 %2, %4"
                 : "=&v"(fa[0]), "=&v"(fa[1]), "=&v"(fb[0]) : "v"(ab), "v"(bb) : "memory");
  }
}
template <int KEEP, int MI, int NI>
DI void frag_wait(u32x4 (&fa)[MI], u32x4 (&fb)[NI]) {
  if constexpr (MI == 4 && NI == 2)
    asm volatile("s_waitcnt lgkmcnt(%6)" : "+v"(fa[0]), "+v"(fa[1]), "+v"(fa[2]), "+v"(fa[3]), "+v"(fb[0]), "+v"(fb[1]) : "n"(KEEP) : "memory");
  else
    asm volatile("s_waitcnt lgkmcnt(%3)" : "+v"(fa[0]), "+v"(fa[1]), "+v"(fb[0]) : "n"(KEEP) : "memory");
}
template <int BM, int BN, class Epi>
DI void gemm_tile(const bf16* __restrict__ A, int lda, const bf16* __restrict__ Bt, int ldb, int nk64, int m0, int n0, char* smem, const Epi& epi) {
  constexpr int RW = BM / 2, CW = BN / 4, MI = RW / 32, NI = CW / 32;
  constexpr int A_BYTES = BM * 64, B_BYTES = BN * 64, STAGE = A_BYTES + B_BYTES, GA = BM / 128, GB = BN / 128, GT = GA + GB;
  const int nk = nk64 * 2;
  const int tid = threadIdx.x, lane = tid & 63, w = tid >> 6;
  const int wm = w >> 2, wn = w & 3, r = lane & 31, h = lane >> 5;
  f32x16 acc[MI][NI];
#pragma unroll
  for (int mi = 0; mi < MI; ++mi)
#pragma unroll
    for (int ni = 0; ni < NI; ++ni)
#pragma unroll
      for (int i = 0; i < 16; ++i) acc[mi][ni][i] = 0.f;
  const int srow = w * 16 + (lane >> 2);
  const int slc = (lane & 3) ^ ((srow >> 2) & 3);
  const bf16* Ag = A + (size_t)(m0 + srow) * lda + slc * 8;
  const bf16* Bg = Bt + (size_t)(n0 + srow) * ldb + slc * 8;
#define GEMM_STAGE(buf, kt)                                                                                                        \
  do {                                                                                                                             \
    char* sa_ = smem + (buf) * STAGE + w * 1024;                                                                                   \
    _Pragma("unroll") for (int i = 0; i < GA; ++i)                                                                                 \
        __builtin_amdgcn_global_load_lds((const unsigned*)(Ag + (size_t)(128 * i) * lda + (kt) * 32), (unsigned*)(sa_ + i * 8192), 16, 0, 0); \
    _Pragma("unroll") for (int i = 0; i < GB; ++i)                                                                                 \
        __builtin_amdgcn_global_load_lds((const unsigned*)(Bg + (size_t)(128 * i) * ldb + (kt) * 32), (unsigned*)(sa_ + A_BYTES + i * 8192), 16, 0, 0); \
  } while (0)
#define WAIT_V(n) asm volatile("s_waitcnt vmcnt(%0)" ::"n"(n) : "memory")
  asm volatile("s_waitcnt vmcnt(0)" ::: "memory");
  GEMM_STAGE(0, 0);
  GEMM_STAGE(1, 1);
  GEMM_STAGE(2, 2);
  int aoff[MI], boff[NI];
#pragma unroll
  for (int mi = 0; mi < MI; ++mi) { const int row = wm * RW + mi * 32 + r; aoff[mi] = row * 64 + ((h ^ ((row >> 2) & 3)) << 4); }
#pragma unroll
  for (int ni = 0; ni < NI; ++ni) { const int row = wn * CW + ni * 32 + r; boff[ni] = A_BYTES + row * 64 + ((h ^ ((row >> 2) & 3)) << 4); }
  constexpr int RD = MI + NI;
  const unsigned sb0 = (unsigned)(size_t)smem;
  u32x4 fa0[MI], fb0[NI], fa1[MI], fb1[NI];
#define GEMM_MMA(FA, FB)                                                                                   \
  _Pragma("unroll") for (int mi = 0; mi < MI; ++mi) _Pragma("unroll") for (int ni = 0; ni < NI; ++ni)      \
      acc[mi][ni] = MFMA32(__builtin_bit_cast(bf16x8, FB[ni]), __builtin_bit_cast(bf16x8, FA[mi]), acc[mi][ni])
  WAIT_V(2 * GT);
  __builtin_amdgcn_s_barrier();
  asm volatile("" ::: "memory");
  frag_read<MI, NI>(fa0, fb0, sb0 + (unsigned)aoff[0], sb0 + (unsigned)boff[0]);
#pragma unroll 1
  for (int kt = 0; kt < nk - 1; ++kt) {
    if (kt + 2 < nk) WAIT_V(GT); else WAIT_V(0);
    __builtin_amdgcn_s_barrier();
    asm volatile("" ::: "memory");
    if (kt + 3 < nk) GEMM_STAGE((kt + 3) & 3, kt + 3);
    const unsigned sc = sb0 + (unsigned)((kt & 3) * STAGE), sn = sb0 + (unsigned)(((kt + 1) & 3) * STAGE);
    frag_read<MI, NI>(fa1, fb1, (sc + (unsigned)aoff[0]) ^ 32u, (sc + (unsigned)boff[0]) ^ 32u);
    frag_wait<RD, MI, NI>(fa0, fb0);
    GEMM_MMA(fa0, fb0);
    frag_read<MI, NI>(fa0, fb0, sn + (unsigned)aoff[0], sn + (unsigned)boff[0]);
    frag_wait<RD, MI, NI>(fa1, fb1);
    GEMM_MMA(fa1, fb1);
  }
  {
    const unsigned sc = sb0 + (unsigned)(((nk - 1) & 3) * STAGE);
    frag_read<MI, NI>(fa1, fb1, (sc + (unsigned)aoff[0]) ^ 32u, (sc + (unsigned)boff[0]) ^ 32u);
    frag_wait<RD, MI, NI>(fa0, fb0);
    GEMM_MMA(fa0, fb0);
    frag_wait<0, MI, NI>(fa1, fb1);
    GEMM_MMA(fa1, fb1);
  }
#undef GEMM_MMA
#undef GEMM_STAGE
#undef WAIT_V
  __syncthreads();
  constexpr int CPB = (BN + 8) * 2, SEGS = BN / 32, ITEMS = BM * SEGS / 512;
#pragma unroll
  for (int mi = 0; mi < MI; ++mi)
#pragma unroll
    for (int ni = 0; ni < NI; ++ni)
#pragma unroll
      for (int g = 0; g < 4; ++g) {
        const int row = wm * RW + mi * 32 + r, col = wn * CW + ni * 32 + 8 * g + 4 * h;
        u32x2 pk = {pack2(acc[mi][ni][4 * g], acc[mi][ni][4 * g + 1]), pack2(acc[mi][ni][4 * g + 2], acc[mi][ni][4 * g + 3])};
        *(u32x2*)(smem + row * CPB + col * 2) = pk;
      }
  __syncthreads();
  typename Epi::Pre pre[ITEMS];
#pragma unroll
  for (int it = 0; it < ITEMS; ++it) {
    const int item = it * 512 + tid, prow = item / SEGS, seg = item % SEGS;
    epi.prefetch(m0 + prow, n0 + seg * 32, pre[it]);
  }
#pragma unroll
  for (int it = 0; it < ITEMS; ++it) {
    const int item = it * 512 + tid, prow = item / SEGS, seg = item % SEGS;
    float v[32];
#pragma unroll
    for (int j = 0; j < 4; ++j) {
      const u32x4 t = *(const u32x4*)(smem + prow * CPB + seg * 64 + 16 * j);
#pragma unroll
      for (int e = 0; e < 4; ++e) { v[8 * j + 2 * e] = bflo(t[e]); v[8 * j + 2 * e + 1] = bfhi(t[e]); }
    }
    epi(m0 + prow, n0 + seg * 32, v, pre[it]);
    if constexpr (Epi::LDS_OUT) {
#pragma unroll
      for (int j = 0; j < 4; ++j) {
        u32x4 o = {pack2(v[8 * j], v[8 * j + 1]), pack2(v[8 * j + 2], v[8 * j + 3]), pack2(v[8 * j + 4], v[8 * j + 5]), pack2(v[8 * j + 6], v[8 * j + 7])};
        *(u32x4*)(smem + prow * CPB + seg * 64 + 16 * j) = o;
      }
    }
  }
  __syncthreads();
  if constexpr (Epi::LDS_OUT) {
    constexpr int CH = BN / 8, NIT = BM * CH / 512;
    bf16* ob = epi.out_base() + (size_t)m0 * epi.out_ld() + n0;
    const int ld = epi.out_ld();
#pragma unroll 4
    for (int it = 0; it < NIT; ++it) {
      const int idx = it * 512 + tid, row = idx / CH, c8 = idx % CH;
      const u32x4 t = *(const u32x4*)(smem + row * CPB + c8 * 16);
      *(u32x4*)(ob + (size_t)row * ld + c8 * 8) = t;
    }
    __syncthreads();
  }
}
template <class Epi>
DI void gemm_phase(const bf16* A, int lda, const bf16* Bt, int ldb, int nk, int MT, int NT, char* smem, const Epi& epi, int g_vb) {
  const int nb = gridDim.x;
  const int vb = g_vb;
  const int U = MT * NT, full = (U / nb) * nb, rem = U - full;
#pragma unroll 1
  for (int u = vb; u < full; u += nb) gemm_tile<256, 256>(A, lda, Bt, ldb, nk, (u / NT) * 256, (u % NT) * 256, smem, epi);
  if (rem * 4 <= nb) {
    const int tvb = (nb & 255) == 0 ? ((vb & 31) * (nb >> 5) + (vb >> 5)) : vb;
#pragma unroll 1
    for (int sidx = tvb; sidx < rem * 4; sidx += nb) {
      const int u = full + (sidx >> 2), q = sidx & 3;
      gemm_tile<128, 128>(A, lda, Bt, ldb, nk, (u / NT) * 256 + (q >> 1) * 128, (u % NT) * 256 + (q & 1) * 128, smem, epi);
    }
  } else {
#pragma unroll 1
    for (int u = full + vb; u < U; u += nb) gemm_tile<256, 256>(A, lda, Bt, ldb, nk, (u / NT) * 256, (u % NT) * 256, smem, epi);
  }
}

template <int NC>
DI void store_bf16(bf16* dst, const float (&v)[NC]) {
#pragma unroll
  for (int j = 0; j < NC / 8; ++j) {
    u32x4 o = {pack2(v[8 * j], v[8 * j + 1]), pack2(v[8 * j + 2], v[8 * j + 3]), pack2(v[8 * j + 4], v[8 * j + 5]), pack2(v[8 * j + 6], v[8 * j + 7])};
    *(u32x4*)(dst + 8 * j) = o;
  }
}
template <int NC>
DI void store_f32(float* dst, const float (&v)[NC]) {
#pragma unroll
  for (int j = 0; j < NC / 4; ++j) { f32x4 o = {v[4 * j], v[4 * j + 1], v[4 * j + 2], v[4 * j + 3]}; *(f32x4*)(dst + 4 * j) = o; }
}
DI void head_rmsnorm(float (&v)[32], const float* gain, int hoff, float post) {
  float ss = 0.f;
#pragma unroll
  for (int j = 0; j < 32; ++j) ss += v[j] * v[j];
  ss += __shfl_xor(ss, 1);
  const float rs = rsqrtf(ss * (1.f / 64.f) + EPS) * post;
#pragma unroll
  for (int j = 0; j < 32; ++j) v[j] = v[j] * rs * gain[hoff + j];
}
DI void rope16(float (&v)[32], int pos, const float* inv) {
#pragma unroll
  for (int i = 0; i < 8; ++i) {
    double rev = (double)pos * (double)inv[i] * 0.15915494309189535;
    rev -= floor(rev);
    const float fr = (float)rev;
    const float sn = __builtin_amdgcn_sinf(fr), cs = __builtin_amdgcn_cosf(fr);
    const float a = v[i], b = v[i + 8];
    v[i] = a * cs - b * sn;
    v[i + 8] = b * cs + a * sn;
  }
}

struct EpiInA {
  static constexpr bool LDS_OUT = true;
  DI bf16* out_base() const { return p.z; }
  DI int out_ld() const { return 2048; }
  const Params& p;
  struct Pre { float rs; };
  DI void prefetch(int row, int col, Pre& q) const { q.rs = p.rstd_a[row]; }
  DI void operator()(int row, int col, float (&v)[32], const Pre& q) const {
    const float rs = q.rs;
#pragma unroll
    for (int j = 0; j < 32; ++j) v[j] *= rs;
    if (col < 768) {
      if (row >= NPR - 15) {
        if (row < NPR) store_f32<32>(p.out + O_POOLP + (size_t)(row - (NPR - 15)) * 768 + col, v);
        else { const int s = row - NPR, b = s >> 3, t = s & 7; store_f32<32>(p.out + O_POOLS + (size_t)(b * 15 + 7 + t) * 768 + col, v); }
      }
    } else if (col < 1536) {
#pragma unroll
      for (int j = 0; j < 32; ++j) v[j] = silu(v[j]);
    } else if (col < 1792) {
      head_rmsnorm(v, p.mem_q_norm, col & 63, 0.125f * LOG2E);
    } else {
#pragma unroll
      for (int j = 0; j < 32; ++j) v[j] = silu(v[j]);
    }
  }
};
struct EpiMemKV {
  static constexpr bool LDS_OUT = false;
  DI bf16* out_base() const { return nullptr; }
  DI int out_ld() const { return 0; }
  const Params& p;
  struct Pre { float rs; };
  DI void prefetch(int row, int col, Pre& q) const { q.rs = p.rstd_mem[row]; }
  DI void operator()(int row, int col, float (&v)[32], const Pre& q) const {
    const float rs = q.rs;
#pragma unroll
    for (int j = 0; j < 32; ++j) v[j] *= rs;
    const int l = col >> 9, wi = col & 511;
    const bool isk = wi < 256;
    if (isk) head_rmsnorm(v, p.mem_k_norm + l * 64, col & 63, 1.f);
    const size_t e = (size_t)(l * 256 + row) * 256 + (wi & 255) + (isk ? 0 : 131072);
    store_f32<32>(p.out + O_MKP + e, v);
    store_bf16<32>(p.mkb + e, v);
  }
};
struct EpiPool {
  static constexpr bool LDS_OUT = false;
  DI bf16* out_base() const { return nullptr; }
  DI int out_ld() const { return 0; }
  const Params& p;
  struct Pre { u32x4 g[4]; };
  DI void prefetch(int row, int col, Pre& pq) const {
    const bf16* gp = p.z + (size_t)row * 2048 + 768 + col;
#pragma unroll
    for (int q = 0; q < 4; ++q) pq.g[q] = *(const u32x4*)(gp + 8 * q);
  }
  DI void operator()(int row, int col, float (&v)[32], const Pre& pq) const {
    const float* sc = p.pool_scale + col;
#pragma unroll
    for (int q = 0; q < 4; ++q) {
      const u32x4 g = pq.g[q];
#pragma unroll
      for (int j = 0; j < 4; ++j) { v[8 * q + 2 * j] *= sc[8 * q + 2 * j] * bflo(g[j]); v[8 * q + 2 * j + 1] *= sc[8 * q + 2 * j + 1] * bfhi(g[j]); }
    }
    store_bf16<32>(p.act + (size_t)row * 1024 + col, v);
  }
};
struct EpiOutA {
  static constexpr bool LDS_OUT = false;
  DI bf16* out_base() const { return nullptr; }
  DI int out_ld() const { return 0; }
  const Params& p;
  struct Pre { u32x4 x[4]; };
  DI void prefetch(int row, int col, Pre& q) const {
    const bf16* xr = p.xb + (size_t)row * 1024 + col;
#pragma unroll
    for (int j = 0; j < 4; ++j) q.x[j] = *(const u32x4*)(xr + 8 * j);
  }
  DI void operator()(int row, int col, float (&v)[32], const Pre& q) const {
    float ss = 0.f;
#pragma unroll
    for (int j = 0; j < 4; ++j)
#pragma unroll
      for (int e = 0; e < 4; ++e) { v[8 * j + 2 * e] += bflo(q.x[j][e]); v[8 * j + 2 * e + 1] += bfhi(q.x[j][e]); }
#pragma unroll
    for (int j = 0; j < 32; ++j) ss += v[j] * v[j];
    ss += __shfl_xor(ss, 1);
    ss += __shfl_xor(ss, 2);
    if ((threadIdx.x & 3) == 0) atomicAdd(p.ssq1 + row, ss);
    store_bf16<32>(p.xb + (size_t)row * 1024 + col, v);
  }
};
struct EpiKVB {
  static constexpr bool LDS_OUT = true;
  DI bf16* out_base() const { return p.z; }
  DI int out_ld() const { return 2560; }
  const Params& p;
  struct Pre { float ssq; };
  DI void prefetch(int row, int col, Pre& q) const { q.ssq = p.ssq1[row]; }
  DI void operator()(int row, int col, float (&v)[32], const Pre& q) const {
    const float rs = rsqrtf(q.ssq * (1.f / 1024.f) + EPS);
#pragma unroll
    for (int j = 0; j < 32; ++j) v[j] *= rs;
    const int pos = row < NPR ? row : NPR + ((row - NPR) & 7);
    if (col < 512) {
      if (col < 256) {
        head_rmsnorm(v, p.k_norm, col & 63, 1.f);
        if ((col & 63) == 0) rope16(v, pos, p.rope_inv);
      }
      const size_t ob = col < 256 ? 0 : (O_SVP - O_SKP);
      const size_t obs = col < 256 ? 0 : (O_SVS - O_SKS);
      const int c = col & 255;
      if (row >= NPR - 128) {
        if (row < NPR) store_f32<32>(p.out + O_SKP + ob + (size_t)(row - (NPR - 128)) * 256 + c, v);
        else { const int s = row - NPR, b = s >> 3, t = s & 7; store_f32<32>(p.out + O_SKS + obs + (size_t)(b * 128 + 120 + t) * 256 + c, v); }
      }
    } else if (col < 1280) {
      head_rmsnorm(v, p.q_norm, col & 63, 0.125f * LOG2E);
      if ((col & 63) == 0) rope16(v, pos, p.rope_inv);
    } else if (col < 2048) {
#pragma unroll
      for (int j = 0; j < 32; ++j) v[j] = silu(v[j]);
    } else if (col < 2304) {
      head_rmsnorm(v, p.mem_q_norm + 64, col & 63, 0.125f * LOG2E);
    } else {
#pragma unroll
      for (int j = 0; j < 32; ++j) v[j] = silu(v[j]);
    }
  }
};
struct EpiOutB {
  static constexpr bool LDS_OUT = false;
  DI bf16* out_base() const { return nullptr; }
  DI int out_ld() const { return 0; }
  const Params& p;
  struct Pre { u32x4 x[4]; };
  DI void prefetch(int row, int col, Pre& q) const {
    const bf16* xr = p.xb + (size_t)row * 1024 + col;
#pragma unroll
    for (int j = 0; j < 4; ++j) q.x[j] = *(const u32x4*)(xr + 8 * j);
  }
  DI void operator()(int row, int col, float (&v)[32], const Pre& q) const {
#pragma unroll
    for (int j = 0; j < 4; ++j)
#pragma unroll
      for (int e = 0; e < 4; ++e) { v[8 * j + 2 * e] += bflo(q.x[j][e]); v[8 * j + 2 * e + 1] += bfhi(q.x[j][e]); }
    store_f32<32>(p.out + O_Y + (size_t)row * 1024 + col, v);
  }
};

template <bool MASKED>
DI void attn_chunk(const bf16x8 (&qf)[4], const char* kimg, const char* vimg, float& m, float& l, f32x16 (&o)[2], int lane, int lo, int hi) {
  const int r = lane & 31, h = lane >> 5;
  f32x16 s[2];
#pragma unroll
  for (int kt = 0; kt < 2; ++kt) {
#pragma unroll
    for (int i = 0; i < 16; ++i) s[kt][i] = 0.f;
#pragma unroll
    for (int ks = 0; ks < 4; ++ks) {
      const int row = kt * 32 + r, chunk = ks * 2 + h;
      const bf16x8 kf = *(const bf16x8*)(kimg + row * 128 + ((chunk ^ ((row >> 1) & 7)) << 4));
      s[kt] = MFMA32(kf, qf[ks], s[kt]);
    }
  }
  float mx = -1e30f;
#pragma unroll
  for (int kt = 0; kt < 2; ++kt)
#pragma unroll
    for (int i = 0; i < 16; ++i) {
      if (MASKED) {
        const int kk = kt * 32 + crow(i, h);
        const bool ok = (kk >= lo) && (kk <= hi);
        s[kt][i] = ok ? s[kt][i] : -1e30f;
      }
      mx = fmaxf(mx, s[kt][i]);
    }
  mx = fmaxf(mx, __shfl_xor(mx, 32));
  const float mn = fmaxf(m, mx);
  const float alpha = __builtin_amdgcn_exp2f(m - mn);
  m = mn;
  float ps = 0.f;
#pragma unroll
  for (int kt = 0; kt < 2; ++kt)
#pragma unroll
    for (int i = 0; i < 16; ++i) {
      const float pv = (!MASKED || s[kt][i] > -1e29f) ? __builtin_amdgcn_exp2f(s[kt][i] - mn) : 0.f;
      s[kt][i] = pv;
      ps += pv;
    }
  l = l * alpha + ps;
#pragma unroll
  for (int dt = 0; dt < 2; ++dt)
#pragma unroll
    for (int i = 0; i < 16; ++i) o[dt][i] *= alpha;
  const int i16 = lane & 15, q = i16 >> 2, pp = i16 & 3, blk = (lane >> 4) & 1;
#pragma unroll
  for (int kt = 0; kt < 2; ++kt)
#pragma unroll
    for (int st = 0; st < 2; ++st) {
      u32x4 pk = {pack2(s[kt][8 * st], s[kt][8 * st + 1]), pack2(s[kt][8 * st + 2], s[kt][8 * st + 3]),
                  pack2(s[kt][8 * st + 4], s[kt][8 * st + 5]), pack2(s[kt][8 * st + 6], s[kt][8 * st + 7])};
      const bf16x8 pf = __builtin_bit_cast(bf16x8, pk);
      const int row = kt * 32 + st * 16 + 4 * h + q;
#pragma unroll
      for (int dt = 0; dt < 2; ++dt) {
        const int cb = (dt * 32 + blk * 16 + pp * 4) * 2;
        const int a0 = row * 128 + (cb ^ (((row >> 1) & 1) << 6));
        const s16x4 lo4 = __builtin_amdgcn_ds_read_tr16_b64_v4i16((s16x4 __attribute__((address_space(3)))*)(vimg + a0));
        const s16x4 hi4 = __builtin_amdgcn_ds_read_tr16_b64_v4i16((s16x4 __attribute__((address_space(3)))*)(vimg + a0 + 8 * 128));
        const bf16x8 vf = __builtin_shufflevector(lo4, hi4, 0, 1, 2, 3, 4, 5, 6, 7);
        o[dt] = MFMA32(vf, pf, o[dt]);
      }
    }
}
DI void attn_store(const f32x16 (&o)[2], float l, int lane, bool valid, bf16* dst, const bf16* gate) {
  const int h = lane >> 5;
  const float lt = l + __shfl_xor(l, 32);
  const float inv = 1.f / lt;
  if (valid) {
#pragma unroll
    for (int dt = 0; dt < 2; ++dt)
#pragma unroll
      for (int g4 = 0; g4 < 4; ++g4) {
        const int d0 = dt * 32 + g4 * 8 + 4 * h;
        const u32x2 gg = *(const u32x2*)(gate + d0);
        u32x2 ov = {pack2(o[dt][4 * g4] * inv * bflo(gg[0]), o[dt][4 * g4 + 1] * inv * bfhi(gg[0])),
                    pack2(o[dt][4 * g4 + 2] * inv * bflo(gg[1]), o[dt][4 * g4 + 3] * inv * bfhi(gg[1]))};
        *(u32x2*)(dst + d0) = ov;
      }
  }
}
DI void attn_store_rows(const f32x16 (&o)[2], float l, int lane, char* slab, bf16* dst0, const bf16* gate0, int ldg) {
  const int r = lane & 31, h = lane >> 5;
  const float lt = l + __shfl_xor(l, 32);
  const float inv = 1.f / lt;
#pragma unroll
  for (int dt = 0; dt < 2; ++dt)
#pragma unroll
    for (int g4 = 0; g4 < 4; ++g4) {
      const int d0 = dt * 32 + g4 * 8 + 4 * h;
      u32x2 ov = {pack2(o[dt][4 * g4] * inv, o[dt][4 * g4 + 1] * inv), pack2(o[dt][4 * g4 + 2] * inv, o[dt][4 * g4 + 3] * inv)};
      *(u32x2*)(slab + r * 144 + d0 * 2) = ov;
    }
  asm volatile("s_waitcnt lgkmcnt(0)" ::: "memory");
#pragma unroll
  for (int i = 0; i < 4; ++i) {
    const int row = i * 8 + (lane >> 3), c8 = lane & 7;
    const u32x4 t = *(const u32x4*)(slab + row * 144 + c8 * 16);
    const u32x4 g = *(const u32x4*)(gate0 + (size_t)row * ldg + c8 * 8);
    u32x4 ov;
#pragma unroll
    for (int e = 0; e < 4; ++e) ov[e] = pack2(bflo(t[e]) * bflo(g[e]), bfhi(t[e]) * bfhi(g[e]));
    *(u32x4*)(dst0 + (size_t)row * 1024 + c8 * 8) = ov;
  }
  asm volatile("s_waitcnt lgkmcnt(0)" ::: "memory");
}
DI void load_q(bf16x8 (&qf)[4], const bf16* qrow, int h) {
#pragma unroll
  for (int ks = 0; ks < 4; ++ks) qf[ks] = *(const bf16x8*)(qrow + ks * 16 + 8 * h);
}
template <int NROWS>
DI void stage_bf16(char* img, const bf16* src, int ld, bool vimg, int zero_below) {
  const int tid = threadIdx.x;
#pragma unroll
  for (int i = 0; i < NROWS / 64; ++i) {
    const int id = tid + 512 * i, row = id >> 3, kc = id & 7;
    u32x4 t = {0u, 0u, 0u, 0u};
    if (row >= zero_below) t = *(const u32x4*)(src + (ptrdiff_t)row * ld + kc * 8);
    const int sw = vimg ? (kc ^ (((row >> 1) & 1) << 2)) : (kc ^ ((row >> 1) & 7));
    *(u32x4*)(img + row * 128 + (sw << 4)) = t;
  }
}

DI void mem_attn_prompt(const Params& p, int layer, int unit, char* smem) {
  const int tt = unit >> 2, hh = unit & 3;
  const int lane = threadIdx.x & 63, w = threadIdx.x >> 6, r = lane & 31, h = lane >> 5;
  const int ldz = layer ? 2560 : 2048, qcol = layer ? 2048 : 1536, gcol = layer ? 2304 : 1792;
  char* kimg = smem; char* vimg = smem + 32768;
  stage_bf16<256>(kimg, p.mkb + (size_t)layer * 65536 + hh * 64, 256, false, 0);
  stage_bf16<256>(vimg, p.mkb + 131072 + (size_t)layer * 65536 + hh * 64, 256, true, 0);
  const int tok = tt * 256 + w * 32 + r;
  bf16x8 qf[4];
  load_q(qf, p.z + (size_t)tok * ldz + qcol + hh * 64, h);
  __syncthreads();
  float m = -1e30f, l = 0.f;
  f32x16 o[2];
#pragma unroll
  for (int dt = 0; dt < 2; ++dt)
#pragma unroll
    for (int i = 0; i < 16; ++i) o[dt][i] = 0.f;
#pragma unroll 1
  for (int c = 0; c < 4; ++c) attn_chunk<false>(qf, kimg + c * 8192, vimg + c * 8192, m, l, o, lane, 0, 63);
  {
    const int tok0 = tt * 256 + w * 32;
    attn_store_rows(o, l, lane, smem + 98304 + w * 4608, p.act + (size_t)tok0 * 1024 + 768 + hh * 64, p.z + (size_t)tok0 * ldz + gcol + hh * 64, ldz);
  }
  __syncthreads();
}
DI void swa_prompt(const Params& p, int unit, char* smem) {
  const int n = unit >> 2, kvh = unit & 3;
  const int lane = threadIdx.x & 63, w = threadIdx.x >> 6, r = lane & 31, h = lane >> 5;
  char* kimg = smem; char* vimg = smem + 49152;
  const bf16* kv0 = p.z + (ptrdiff_t)(n * 256 - 128) * 2560 + kvh * 64;
  const int zb = n == 0 ? 128 : 0;
  stage_bf16<384>(kimg, kv0, 2560, false, zb);
  stage_bf16<384>(vimg, kv0 + 256, 2560, true, zb);
  __syncthreads();
  const int t = w * 32 + r, tok = n * 256 + t;
  const int klo = (n == 0 && t + 1 < 128) ? 128 : t + 1, khi = t + 128;
  const int c0 = (32 * w + 1) >> 6, c1 = (32 * w + 159) >> 6;
#pragma unroll 1
  for (int g = 0; g < 3; ++g) {
    const int head = kvh * 3 + g;
    bf16x8 qf[4];
    load_q(qf, p.z + (size_t)tok * 2560 + 512 + head * 64, h);
    float m = p.sinks[head] * LOG2E, l = h == 0 ? 1.f : 0.f;
    f32x16 o[2];
#pragma unroll
    for (int dt = 0; dt < 2; ++dt)
#pragma unroll
      for (int i = 0; i < 16; ++i) o[dt][i] = 0.f;
#pragma unroll 1
    for (int c = c0; c <= c1; ++c) attn_chunk<true>(qf, kimg + c * 8192, vimg + c * 8192, m, l, o, lane, klo - 64 * c, khi - 64 * c);
    attn_store_rows(o, l, lane, smem + 98304 + w * 4608, p.act + (size_t)(n * 256 + w * 32) * 1024 + head * 64, p.z + (size_t)(n * 256 + w * 32) * 2560 + 1280 + head * 64, 2560);
  }
  __syncthreads();
}
template <bool SWA>
DI void stage_wave_kv(char* kimg, char* vimg, const float* ksrc, const float* vsrc, int key0, int nvalid, const bf16* extra, int nextra, int head,
                      float* kcopy, float* vcopy, int lane) {
  f32x4 ka[8], kb[8], va[8], vb[8];
#pragma unroll
  for (int i = 0; i < 8; ++i) {
    const int id = lane + 64 * i, key = id >> 3, kc = id & 7, kk = key0 + key;
    ka[i] = kb[i] = va[i] = vb[i] = (f32x4){0.f, 0.f, 0.f, 0.f};
    if (kk < nvalid) {
      const size_t o = (size_t)kk * 256 + head * 64 + kc * 8;
      ka[i] = *(const f32x4*)(ksrc + o); kb[i] = *(const f32x4*)(ksrc + o + 4);
      va[i] = *(const f32x4*)(vsrc + o); vb[i] = *(const f32x4*)(vsrc + o + 4);
    } else if (SWA && kk - nvalid < nextra) {
      const bf16* e = extra + (size_t)(kk - nvalid) * 2560 + head * 64 + kc * 8;
      ka[i] = __builtin_bit_cast(f32x4, *(const u32x4*)e); va[i] = __builtin_bit_cast(f32x4, *(const u32x4*)(e + 256));
    }
  }
#pragma unroll
  for (int i = 0; i < 8; ++i) {
    const int id = lane + 64 * i, key = id >> 3, kc = id & 7, kk = key0 + key;
    u32x4 tk = __builtin_bit_cast(u32x4, ka[i]), tv = __builtin_bit_cast(u32x4, va[i]);
    if (kk < nvalid) {
      if (SWA && kk >= 8) {
        const size_t o = (size_t)(kk - 8) * 256 + head * 64 + kc * 8;
        *(f32x4*)(kcopy + o) = ka[i]; *(f32x4*)(kcopy + o + 4) = kb[i];
        *(f32x4*)(vcopy + o) = va[i]; *(f32x4*)(vcopy + o + 4) = vb[i];
      }
      tk = (u32x4){pack2(ka[i][0], ka[i][1]), pack2(ka[i][2], ka[i][3]), pack2(kb[i][0], kb[i][1]), pack2(kb[i][2], kb[i][3])};
      tv = (u32x4){pack2(va[i][0], va[i][1]), pack2(va[i][2], va[i][3]), pack2(vb[i][0], vb[i][1]), pack2(vb[i][2], vb[i][3])};
    }
    *(u32x4*)(kimg + key * 128 + ((kc ^ ((key >> 1) & 7)) << 4)) = tk;
    *(u32x4*)(vimg + key * 128 + ((kc ^ (((key >> 1) & 1) << 2)) << 4)) = tv;
  }
}
template <bool SWA>
DI void decode_unit(const Params& p, int layer, int unit, char* smem) {
  const int tid = threadIdx.x, lane = tid & 63, w = tid >> 6, r = lane & 31, h = lane >> 5;
  const int b = unit >> 1, hd = (unit & 1) * 2 + (w >> 2), c = w & 3;
  const int ldz = (SWA || layer) ? 2560 : 2048;
  char* kimg = smem + w * 16384; char* vimg = kimg + 8192;
  const int t = r & 7, g = SWA ? ((r >> 3) > 2 ? 2 : (r >> 3)) : 0;
  const int qhead = SWA ? hd * 3 + g : hd;
  const int qcol = SWA ? 512 : (layer ? 2048 : 1536);
  const int tok = NPR + b * 8 + t;
  bf16x8 qf[4];
  load_q(qf, p.z + (size_t)tok * ldz + qcol + qhead * 64, h);
  const bool active = SWA ? (c < 3) : true;
  if (active) {
    if (SWA) {
      const bf16* knew = p.z + (size_t)(NPR + b * 8) * 2560;
      stage_wave_kv<true>(kimg, vimg, p.cswk + (size_t)b * 32768, p.cswv + (size_t)b * 32768, c * 64, 128, knew, 8, hd,
                          p.out + O_SKS + (size_t)b * 32768, p.out + O_SVS + (size_t)b * 32768, lane);
    } else {
      stage_wave_kv<false>(kimg, vimg, p.cmk + ((size_t)layer * 128 + b) * 65536, p.cmv + ((size_t)layer * 128 + b) * 65536, c * 64, 256, nullptr, 0, hd,
                           nullptr, nullptr, lane);
    }
  }
  __syncthreads();
  float m = -1e30f, l = 0.f;
  if (SWA && c == 0) { m = p.sinks[qhead] * LOG2E; l = h == 0 ? 1.f : 0.f; }
  f32x16 o[2];
#pragma unroll
  for (int dt = 0; dt < 2; ++dt)
#pragma unroll
    for (int i = 0; i < 16; ++i) o[dt][i] = 0.f;
  if (active) attn_chunk<SWA>(qf, kimg, vimg, m, l, o, lane, SWA ? t + 1 - 64 * c : 0, SWA ? t + 128 - 64 * c : 63);
  __syncthreads();
  float* R = (float*)(smem + w * 16384);
  const float lt = l + __shfl_xor(l, 32);
#pragma unroll
  for (int dt = 0; dt < 2; ++dt)
#pragma unroll
    for (int i = 0; i < 16; ++i) R[(dt * 32 + crow(i, h)) * 32 + r] = o[dt][i];
  if (h == 0) { R[2048 + r] = m; R[2080 + r] = lt; }
  __syncthreads();
  const int head2 = tid >> 8, slot = (tid & 255) >> 3, dg = tid & 7;
  if (slot < (SWA ? 24 : 8)) {
    float mc[4], lc[4], M = -1e30f;
#pragma unroll
    for (int cc = 0; cc < 4; ++cc) {
      const float* Rc = (const float*)(smem + (head2 * 4 + cc) * 16384);
      mc[cc] = Rc[2048 + slot]; lc[cc] = Rc[2080 + slot];
      M = fmaxf(M, mc[cc]);
    }
    float L = 0.f, a8[8];
#pragma unroll
    for (int e = 0; e < 8; ++e) a8[e] = 0.f;
#pragma unroll
    for (int cc = 0; cc < 4; ++cc) {
      const float* Rc = (const float*)(smem + (head2 * 4 + cc) * 16384);
      const float wgt = __builtin_amdgcn_exp2f(mc[cc] - M);
      L += wgt * lc[cc];
#pragma unroll
      for (int e = 0; e < 8; ++e) a8[e] += wgt * Rc[(dg * 8 + e) * 32 + slot];
    }
    const float inv = 1.f / L;
    const int hd2 = (unit & 1) * 2 + head2, t2 = slot & 7, g2 = slot >> 3;
    const int tok2 = NPR + b * 8 + t2;
    const int ocol = SWA ? (hd2 * 3 + g2) * 64 : 768 + hd2 * 64;
    const int gcol = SWA ? 1280 + (hd2 * 3 + g2) * 64 : (layer ? 2304 : 1792) + hd2 * 64;
    const u32x4 gg = *(const u32x4*)(p.z + (size_t)tok2 * ldz + gcol + dg * 8);
    u32x4 ov;
#pragma unroll
    for (int e = 0; e < 4; ++e) ov[e] = pack2(a8[2 * e] * inv * bflo(gg[e]), a8[2 * e + 1] * inv * bfhi(gg[e]));
    *(u32x4*)(p.act + (size_t)tok2 * 1024 + ocol + dg * 8) = ov;
  }
  __syncthreads();
}
template <int W>
DI void pool_d_item(const Params& p, int tok, int c0, bf16* __restrict__ dbuf) {
  const bf16* __restrict__ zz = p.z;
  float a[8];
#pragma unroll
  for (int j = 0; j < 8; ++j) a[j] = 0.f;
  u32x4 u0 = {0u, 0u, 0u, 0u};
  float cnt;
  if (tok < NPR) {
    const int nr = tok + 1 < W ? tok + 1 : W;
    cnt = (float)nr;
    u32x4 t[W];
#pragma unroll
    for (int j = 0; j < W; ++j) { const int rr = tok - j < 0 ? 0 : tok - j; t[j] = *(const u32x4*)(zz + (size_t)rr * 2048 + c0); }
    u0 = t[0];
#pragma unroll
    for (int j = 0; j < W; ++j) {
      const float vm = j < nr ? 1.f : 0.f;
#pragma unroll
      for (int e = 0; e < 4; ++e) { a[2 * e] += vm * bflo(t[j][e]); a[2 * e + 1] += vm * bfhi(t[j][e]); }
    }
  } else {
    const int s = tok - NPR, b = s >> 3, t8 = s & 7;
    cnt = (float)W;
    u0 = *(const u32x4*)(zz + (size_t)tok * 2048 + c0);
#pragma unroll
    for (int j = 0; j < W; ++j) {
      const int tt = t8 - j;
      if (tt >= 0) {
        const u32x4 t = *(const u32x4*)(zz + (size_t)(tok - j) * 2048 + c0);
#pragma unroll
        for (int e = 0; e < 4; ++e) { a[2 * e] += bflo(t[e]); a[2 * e + 1] += bfhi(t[e]); }
      } else {
        const float* sp = p.state_pool + (size_t)(b * 15 + 15 + tt) * 768 + c0;
        const f32x4 x0 = *(const f32x4*)sp, x1 = *(const f32x4*)(sp + 4);
        a[0] += x0[0]; a[1] += x0[1]; a[2] += x0[2]; a[3] += x0[3]; a[4] += x1[0]; a[5] += x1[1]; a[6] += x1[2]; a[7] += x1[3];
      }
    }
  }
  const float ic = 1.f / cnt;
  u32x4 o;
#pragma unroll
  for (int e = 0; e < 4; ++e) o[e] = pack2(a[2 * e] * ic - bflo(u0[e]), a[2 * e + 1] * ic - bfhi(u0[e]));
  *(u32x4*)(dbuf + (size_t)tok * 768 + c0) = o;
}

DI void transpose_tile(const float* src, int K, int N, const float* gain, bf16* dst, int tile, char* smem, bool valid) {
  const int tid = threadIdx.x & 255;
  float* T = (float*)(smem + (threadIdx.x >> 8) * 16640);
  const int ntn = N >> 6, k0 = (tile / ntn) << 6, n0 = (tile % ntn) << 6;
  const int c4 = tid & 15, ri = tid >> 4;
  if (valid) {
#pragma unroll
    for (int i = 0; i < 4; ++i) {
      const int k = ri + 16 * i;
      f32x4 t = *(const f32x4*)(src + (size_t)(k0 + k) * N + n0 + c4 * 4);
      const float gsc = gain ? gain[k0 + k] : 1.f;
      T[k * 65 + c4 * 4] = t[0] * gsc; T[k * 65 + c4 * 4 + 1] = t[1] * gsc; T[k * 65 + c4 * 4 + 2] = t[2] * gsc; T[k * 65 + c4 * 4 + 3] = t[3] * gsc;
    }
  }
  __syncthreads();
  const int k8 = tid & 7, nn = tid >> 3;
  if (valid) {
#pragma unroll
    for (int i = 0; i < 2; ++i) {
      const int n = nn + 32 * i;
      const float* tp = T + (k8 * 8) * 65 + n;
      u32x4 o = {pack2(tp[0], tp[65]), pack2(tp[130], tp[195]), pack2(tp[260], tp[325]), pack2(tp[390], tp[455])};
      *(u32x4*)(dst + (size_t)(n0 + n) * K + k0 + k8 * 8) = o;
    }
  }
  __syncthreads();
}
DI void row_prep(const float* src, bf16* dst, float* rstd, int lane) {
  float ss = 0.f;
  f32x4 t[4];
#pragma unroll
  for (int i = 0; i < 4; ++i) { t[i] = *(const f32x4*)(src + i * 256 + lane * 4); ss += t[i][0] * t[i][0] + t[i][1] * t[i][1] + t[i][2] * t[i][2] + t[i][3] * t[i][3]; }
#pragma unroll
  for (int o = 32; o > 0; o >>= 1) ss += __shfl_xor(ss, o);
#pragma unroll
  for (int i = 0; i < 4; ++i) { u32x2 ov = {pack2(t[i][0], t[i][1]), pack2(t[i][2], t[i][3])}; *(u32x2*)(dst + i * 256 + lane * 4) = ov; }
  if (lane == 0) *rstd = rsqrtf(ss * (1.f / 1024.f) + EPS);
}

#define XB_TMO      128
#define XB_XCNT(j)  (256  + 64 * (j))
#define XB_XSUB(j)  (1280 + 64 * (j))
#define XB_XGEN(j)  (2304 + 64 * (j))
#define XB_TOP      3328
#define XB_TOPGEN   3392
#define XCD_BAR_WORDS 3456
#define XB_FLAG 3520
#define XB_ALL_WORDS 3584
#define XB_SPIN_CAP (1u << 18)
#define LAS __attribute__((address_space(3)))
DI unsigned xb_ld(unsigned* p) { return __hip_atomic_load(p, __ATOMIC_RELAXED, __HIP_MEMORY_SCOPE_AGENT); }
DI unsigned xb_add(unsigned* p, unsigned v) { return __hip_atomic_fetch_add(p, v, __ATOMIC_RELAXED, __HIP_MEMORY_SCOPE_AGENT); }
DI unsigned xb_xcc_id() { return (unsigned)__builtin_amdgcn_s_getreg((3 << 11) | 20) & 0xFu; }
#define XB_SPIN(cond, bar) do { unsigned _sp = 0; while (cond) { __builtin_amdgcn_s_sleep(1); \
    if ((++_sp & 255u) == 0u) { if (xb_ld(&(bar)[XB_TMO])) break; if (_sp > XB_SPIN_CAP) { atomicAdd(&(bar)[XB_TMO], 1u); break; } } } } while (0)
struct XcdBarrier { unsigned* bar; unsigned x; volatile LAS unsigned* st; };
DI XcdBarrier xcd_barrier_post(unsigned* bar, volatile LAS unsigned* st) {
  XcdBarrier b; b.bar = bar; b.x = xb_xcc_id(); b.st = st;
  if (threadIdx.x == 0) st[2] = xb_add(&bar[XB_XCNT(b.x)], 1u);
  return b;
}
DI void xcd_barrier_complete(unsigned* bar, unsigned x, unsigned& nloc, unsigned& nx) {
  const unsigned G = gridDim.x * gridDim.y * gridDim.z;
  unsigned sum, cnt, mine, sp = 0u;
  for (;;) {
    sum = 0u; cnt = 0u; mine = 0u;
#pragma unroll
    for (unsigned j = 0; j < 16; ++j) { const unsigned c = xb_ld(&bar[XB_XCNT(j)]); sum += c; cnt += (c > 0u) ? 1u : 0u; mine = (j == x) ? c : mine; }
    if (sum == G) break;
    __builtin_amdgcn_s_sleep(1);
    if ((++sp & 255u) == 0u) { if (xb_ld(&bar[XB_TMO])) break; if (sp > XB_SPIN_CAP) { atomicAdd(&bar[XB_TMO], 1u); break; } }
  }
  nloc = mine > 0u ? mine : 1u; nx = cnt > 0u ? cnt : 1u;
}
DI void xcd_barrier(const XcdBarrier& b) {
  asm volatile("s_waitcnt vmcnt(0)" ::: "memory");
  __syncthreads();
  if (threadIdx.x == 0) {
    unsigned* bar = b.bar;
    __builtin_amdgcn_s_waitcnt(0);
    unsigned nloc = b.st[0], nx = b.st[1];
    if (nloc == 0u) { xcd_barrier_complete(bar, b.x, nloc, nx); b.st[0] = nloc; b.st[1] = nx; }
    const unsigned old = xb_add(&bar[XB_XSUB(b.x)], 1u);
    const unsigned gen = old / nloc;
    if (old + 1u == (gen + 1u) * nloc) {
      __builtin_amdgcn_fence(__ATOMIC_RELEASE, "agent");
      asm volatile("s_waitcnt vmcnt(0)" ::: "memory");
      const unsigned og = xb_add(&bar[XB_TOP], 1u);
      const unsigned tg = og / nx;
      if (og + 1u == (tg + 1u) * nx) xb_add(&bar[XB_TOPGEN], 1u);
      else XB_SPIN(xb_ld(&bar[XB_TOPGEN]) == tg, bar);
      __builtin_amdgcn_fence(__ATOMIC_ACQUIRE, "agent");
      xb_add(&bar[XB_XGEN(b.x)], 1u);
      asm volatile("s_waitcnt vmcnt(0)" ::: "memory");
    } else {
      XB_SPIN(xb_ld(&bar[XB_XGEN(b.x)]) == gen, bar);
      __builtin_amdgcn_fence(__ATOMIC_ACQUIRE, "agent");
      asm volatile("s_waitcnt vmcnt(0)" ::: "memory");
    }
  }
  __syncthreads();
}

template <int PH>
DI void run_phase(const Params& p, char* smem, int vbid) {
  const int bid = blockIdx.x, nb = gridDim.x, tid = threadIdx.x, NT = 512;
  if constexpr (PH == 0) {
    {
      const int lane = tid & 63, w = tid >> 6;
#pragma unroll 1
      for (int u = bid; u < (NTOK + 256) / 16; u += nb) {
        const int row0 = u * 16 + w * 2;
        f32x4 t[2][4];
        const float* src[2]; bf16* dst[2]; float* rs[2];
#pragma unroll
        for (int q = 0; q < 2; ++q) {
          const int row = row0 + q;
          if (row < NTOK) { src[q] = xrow(p, row); dst[q] = p.xb + (size_t)row * 1024; rs[q] = p.rstd_a + row; }
          else { src[q] = p.memp + (size_t)(row - NTOK) * 1024; dst[q] = p.memb + (size_t)(row - NTOK) * 1024; rs[q] = p.rstd_mem + (row - NTOK); }
#pragma unroll
          for (int i = 0; i < 4; ++i) t[q][i] = *(const f32x4*)(src[q] + i * 256 + lane * 4);
        }
#pragma unroll
        for (int q = 0; q < 2; ++q) {
          float ss = 0.f;
#pragma unroll
          for (int i = 0; i < 4; ++i) ss += t[q][i][0] * t[q][i][0] + t[q][i][1] * t[q][i][1] + t[q][i][2] * t[q][i][2] + t[q][i][3] * t[q][i][3];
#pragma unroll
          for (int o = 32; o > 0; o >>= 1) ss += __shfl_xor(ss, o);
#pragma unroll
          for (int i = 0; i < 4; ++i) { u32x2 ov = {pack2(t[q][i][0], t[q][i][1]), pack2(t[q][i][2], t[q][i][3])}; *(u32x2*)(dst[q] + i * 256 + lane * 4) = ov; }
          if (lane == 0) *rs[q] = rsqrtf(ss * (1.f / 1024.f) + EPS);
        }
      }
    }
#pragma unroll 1
    for (int u = bid; u < 978; u += nb) {
      int t = u * 2 + (tid >> 8);
      const float* src; const float* gain = nullptr; bf16* dst; int K = 1024, N = 1024;
      if (t < 512) { src = p.w_in_a; N = 2048; gain = p.norm_a; dst = p.Wt_in_a; }
      else if ((t -= 512) < 256) { src = p.w_out_a; dst = p.Wt_out_a; }
      else if ((t -= 256) < 128) { src = p.w_kv; N = 512; gain = p.kv_norm; dst = p.Wt_kvb; }
      else if ((t -= 128) < 512) { src = p.w_in_b; N = 2048; gain = p.norm_b; dst = p.Wt_kvb + 512 * 1024; }
      else if ((t -= 512) < 256) { src = p.w_out_b; dst = p.Wt_out_b; }
      else if ((t -= 256) < 256) { const int l = t >> 7; t &= 127; src = p.w_mem_kv + (size_t)l * 1024 * 512; N = 512; gain = p.mem_norm + l * 1024; dst = p.Wt_mem + (size_t)l * 512 * 1024; }
      else { t -= 256; const int g = t / 9; t %= 9; src = p.pool_mix_w + (size_t)g * 192 * 192; K = 192; N = 192; dst = p.Wt_pool + (size_t)g * 192 * 768 + g * 192; }
      if (K == 192) {
        const int ltid = tid & 255;
        float* T = (float*)(smem + (tid >> 8) * 16640);
        const int k0 = (t / 3) << 6, n0 = (t % 3) << 6, c4 = ltid & 15, ri = ltid >> 4;
#pragma unroll
        for (int i = 0; i < 4; ++i) {
          const int k = ri + 16 * i;
          f32x4 x = *(const f32x4*)(src + (size_t)(k0 + k) * 192 + n0 + c4 * 4);
          T[k * 65 + c4 * 4] = x[0]; T[k * 65 + c4 * 4 + 1] = x[1]; T[k * 65 + c4 * 4 + 2] = x[2]; T[k * 65 + c4 * 4 + 3] = x[3];
        }
      }
      if (K != 192) transpose_tile(src, K, N, gain, dst, t, smem, true);
      else {
        __syncthreads();
        const int ltid = tid & 255, k8 = ltid & 7, nn = ltid >> 3;
        const float* T = (const float*)(smem + (tid >> 8) * 16640);
        const int k0 = (t / 3) << 6, n0 = (t % 3) << 6;
#pragma unroll
        for (int i = 0; i < 2; ++i) {
          const int n = nn + 32 * i;
          const float* tp = T + (k8 * 8) * 65 + n;
          u32x4 o = {pack2(tp[0], tp[65]), pack2(tp[130], tp[195]), pack2(tp[260], tp[325]), pack2(tp[390], tp[455])};
          *(u32x4*)(dst + (size_t)(n0 + n) * 768 + k0 + k8 * 8) = o;
        }
        __syncthreads();
      }
    }
    for (int i = bid * NT + tid; i < 768 * 96; i += nb * NT) {
      const int n = i / 96, k8 = i % 96;
      if (n / 192 != k8 / 24) { u32x4 zz = {0u, 0u, 0u, 0u}; *(u32x4*)(p.Wt_pool + (size_t)n * 768 + k8 * 8) = zz; }
    }
    for (int i = bid * NT + tid; i < NTOK; i += nb * NT) p.ssq1[i] = 0.f;
    for (int i = bid * NT + tid; i < 128 * 7 * 192; i += nb * NT) {
      const int b = i / (7 * 192), rem = i % (7 * 192);
      *(f32x4*)(p.out + O_POOLS + (size_t)b * 15 * 768 + rem * 4) = *(const f32x4*)(p.state_pool + (size_t)b * 15 * 768 + 8 * 768 + rem * 4);
    }
  } else if constexpr (PH == 1) {
    gemm_phase(p.xb, 1024, p.Wt_in_a, 1024, 16, 68, 8, smem, EpiInA{p}, vbid);
#pragma unroll 1
    for (int v = nb - 1 - ((nb & 255) == 0 ? ((vbid & 31) * (nb >> 5) + (vbid >> 5)) : vbid); v < 16; v += nb) gemm_tile<128, 128>(p.memb, 1024, p.Wt_mem, 1024, 16, (v >> 3) * 128, (v & 7) * 128, smem, EpiMemKV{p});
  } else if constexpr (PH == 2) {
#pragma unroll 1
    for (int u = bid; u < 256; u += nb) mem_attn_prompt(p, 0, u, smem);
    {
      bf16* dbuf = p.dbuf;
      const int lane = tid & 63, gw = bid * 8 + (tid >> 6), nw = nb * 8;
#pragma unroll 1
      for (int it = gw; it < (NTOK / 8) * 4; it += nw) {
        const int tg = it >> 2, g = it & 3;
        const int tok = tg * 8 + (lane >> 3), c0 = g * 192 + (lane & 7) * 8;
        if (g == 0) { pool_d_item<2>(p, tok, c0, dbuf); pool_d_item<2>(p, tok, c0 + 64, dbuf); pool_d_item<2>(p, tok, c0 + 128, dbuf); }
        else if (g == 1) { pool_d_item<4>(p, tok, c0, dbuf); pool_d_item<4>(p, tok, c0 + 64, dbuf); pool_d_item<4>(p, tok, c0 + 128, dbuf); }
        else if (g == 2) { pool_d_item<8>(p, tok, c0, dbuf); pool_d_item<8>(p, tok, c0 + 64, dbuf); pool_d_item<8>(p, tok, c0 + 128, dbuf); }
        else { pool_d_item<16>(p, tok, c0, dbuf); pool_d_item<16>(p, tok, c0 + 64, dbuf); pool_d_item<16>(p, tok, c0 + 128, dbuf); }
      }
    }
  } else if constexpr (PH == 3) {
    const int vb = vbid, NG = 68 * 3;
    if (nb >= NG + 32) {
      if (vb < NG) {
        const int mt = vb / 3, nt = vb % 3;
        gemm_tile<256, 256>(p.dbuf + nt * 192, 768, p.Wt_pool + nt * 192, 768, 6, mt * 256, nt * 256, smem, EpiPool{p});
      } else {
#pragma unroll 1
        for (int u = vb - NG; u < 256; u += nb - NG) decode_unit<false>(p, 0, u, smem);
      }
    } else {
#pragma unroll 1
      for (int u = vb; u < NG; u += nb) {
        const int mt = u / 3, nt = u % 3;
        gemm_tile<256, 256>(p.dbuf + nt * 192, 768, p.Wt_pool + nt * 192, 768, 6, mt * 256, nt * 256, smem, EpiPool{p});
      }
#pragma unroll 1
      for (int u = bid; u < 256; u += nb) decode_unit<false>(p, 0, u, smem);
    }
  } else if constexpr (PH == 4) {
    if (nb == 256) {
      const int u = vbid;
      gemm_tile<256, 256>(p.act, 1024, p.Wt_out_a, 1024, 16, (u >> 2) * 256, (u & 3) * 256, smem, EpiOutA{p});
    } else {
      gemm_phase(p.act, 1024, p.Wt_out_a, 1024, 16, 68, 4, smem, EpiOutA{p}, vbid);
    }
  } else if constexpr (PH == 5) {
    if (nb == 256) {
      if (vbid >= 192) {
        const int sidx = vbid - 192, u4 = 256 + (sidx >> 2), q = sidx & 3;
        gemm_tile<128, 128>(p.act, 1024, p.Wt_out_a, 1024, 16, (u4 >> 2) * 256 + (q >> 1) * 128, (u4 & 3) * 256 + (q & 1) * 128, smem, EpiOutA{p});
        asm volatile("s_waitcnt vmcnt(0)" ::: "memory");
        __syncthreads();
        if (tid == 0) {
          __builtin_amdgcn_fence(__ATOMIC_RELEASE, "agent");
          asm volatile("s_waitcnt vmcnt(0)" ::: "memory");
          (void)xb_add(&p.bar[XB_FLAG], 1u);
        }
      }
#pragma unroll 1
      for (int u = vbid; u < 680; u += nb) {
        int mt = u / 10;
        const int nt = u % 10;
        if (u >= 640) {
          if (tid == 0) {
            XB_SPIN(xb_ld(&p.bar[XB_FLAG]) < 64u, p.bar);
            __builtin_amdgcn_fence(__ATOMIC_ACQUIRE, "agent");
            asm volatile("s_waitcnt vmcnt(0)" ::: "memory");
          }
          __syncthreads();
        }
        gemm_tile<256, 256>(p.xb, 1024, p.Wt_kvb, 1024, 16, mt * 256, nt * 256, smem, EpiKVB{p});
      }
    } else {
      gemm_phase(p.xb, 1024, p.Wt_kvb, 1024, 16, 68, 10, smem, EpiKVB{p}, vbid);
    }
  } else if constexpr (PH == 6) {
#pragma unroll 1
    for (int u = bid; u < 256; u += nb) swa_prompt(p, u, smem);
#pragma unroll 1
    for (int u = bid; u < 256; u += nb) mem_attn_prompt(p, 1, u, smem);
#pragma unroll 1
    for (int u = bid; u < 256; u += nb) decode_unit<true>(p, 1, u, smem);
#pragma unroll 1
    for (int u = bid; u < 256; u += nb) decode_unit<false>(p, 1, u, smem);
  } else if constexpr (PH == 7) {
    gemm_phase(p.act, 1024, p.Wt_out_b, 1024, 16, 68, 4, smem, EpiOutB{p}, vbid);
  }
}

#if MULTI_LAUNCH
template <int PH>
__global__ void __launch_bounds__(512) phase_kernel(Params p) {
  __shared__ __attribute__((aligned(1024))) char smem[135168];
  run_phase<PH>(p, smem, blockIdx.x);
}
#else
__global__ void __launch_bounds__(512) yoco_megakernel(Params p) {
  __shared__ __attribute__((aligned(1024))) char smem[135168];
  __shared__ uint4 xb_words;
  if (threadIdx.x == 0) xb_words = make_uint4(0u, 0u, 0u, 0u);
  __syncthreads();
  XcdBarrier xb = xcd_barrier_post(p.bar, (volatile LAS unsigned*)&xb_words);
  run_phase<0>(p, smem, blockIdx.x); xcd_barrier(xb);
  if (threadIdx.x == 0) {
    const unsigned per = gridDim.x >> 3;
    bool even = (gridDim.x & 7u) == 0u;
    for (unsigned j = 0; j < 16; ++j) { const unsigned c = xb_ld(&p.bar[XB_XCNT(j)]); even = even && (j < 8 ? c == per : c == 0u); }
    const unsigned rank = ((volatile LAS unsigned*)&xb_words)[2];
    ((volatile LAS unsigned*)&xb_words)[3] = even ? xb.x * per + rank : blockIdx.x;
  }
  __syncthreads();
  const int vbid = (int)((volatile LAS unsigned*)&xb_words)[3];
  run_phase<1>(p, smem, vbid); xcd_barrier(xb);
  run_phase<2>(p, smem, vbid); xcd_barrier(xb);
  run_phase<3>(p, smem, vbid); xcd_barrier(xb);
  run_phase<4>(p, smem, vbid); xcd_barrier(xb);
  run_phase<5>(p, smem, vbid); xcd_barrier(xb);
  run_phase<6>(p, smem, vbid); xcd_barrier(xb);
  run_phase<7>(p, smem, vbid);
}
#endif

extern "C" void kernel_launch(void* const* d_in, const int* in_sizes, int n_in, void* d_out, int out_size, void* d_ws, size_t ws_size, hipStream_t stream) {
  Params p{};
  const float* const* in = (const float* const*)d_in;
  p.xp = in[0]; p.xs = in[1]; p.state_pool = in[2]; p.cswk = in[3]; p.cswv = in[4]; p.cmk = in[5]; p.cmv = in[6]; p.memp = in[7];
  p.norm_a = in[8]; p.w_in_a = in[9]; p.pool_mix_w = in[10]; p.pool_scale = in[11]; p.w_out_a = in[12]; p.kv_norm = in[13]; p.w_kv = in[14];
  p.k_norm = in[15]; p.norm_b = in[16]; p.w_in_b = in[17]; p.q_norm = in[18]; p.sinks = in[19]; p.w_out_b = in[20]; p.mem_norm = in[21];
  p.w_mem_kv = in[22]; p.mem_q_norm = in[23]; p.mem_k_norm = in[24];
  p.out = (float*)d_out;
  char* ws = (char*)d_ws;
  size_t off = 0;
  auto take = [&](size_t bytes) { char* r = ws + off; off += (bytes + 255) & ~(size_t)255; return r; };
  p.Wt_in_a = (bf16*)take((size_t)2048 * 1024 * 2);
  p.Wt_out_a = (bf16*)take((size_t)1024 * 1024 * 2);
  p.Wt_kvb = (bf16*)take((size_t)2560 * 1024 * 2);
  p.Wt_out_b = (bf16*)take((size_t)1024 * 1024 * 2);
  p.Wt_mem = (bf16*)take((size_t)1024 * 1024 * 2);
  p.Wt_pool = (bf16*)take((size_t)768 * 768 * 2);
  p.memb = (bf16*)take((size_t)256 * 1024 * 2);
  p.mkb = (bf16*)take((size_t)4 * 256 * 256 * 2);
  p.rstd_a = (float*)take((size_t)NTOK * 4);
  p.rstd_mem = (float*)take(256 * 4);
  p.ssq1 = (float*)take((size_t)NTOK * 4);
  p.bar = (unsigned*)take((size_t)XB_ALL_WORDS * 4);
  p.xb = (bf16*)take((size_t)NTOK * 1024 * 2);
  p.act = (bf16*)take((size_t)NTOK * 1024 * 2);
  p.dbuf = (bf16*)take((size_t)NTOK * 768 * 2);
  p.z = (bf16*)take((size_t)NTOK * 2560 * 2);
  for (int i = 0; i < 8; ++i) p.rope_inv[i] = powf(500000.0f, -(float)i / 8.0f);
#if MULTI_LAUNCH
  const int grid = 256;
  phase_kernel<0><<<grid, 512, 0, stream>>>(p);
  phase_kernel<1><<<grid, 512, 0, stream>>>(p);
  phase_kernel<2><<<grid, 512, 0, stream>>>(p);
  phase_kernel<3><<<grid, 512, 0, stream>>>(p);
  phase_kernel<4><<<grid, 512, 0, stream>>>(p);
  phase_kernel<5><<<grid, 512, 0, stream>>>(p);
  phase_kernel<6><<<grid, 512, 0, stream>>>(p);
  phase_kernel<7><<<grid, 512, 0, stream>>>(p);
#else
  static int grid_blocks = 0;
  if (!grid_blocks) {
    int dev = 0, cus = 0, per_cu = 0;
    hipGetDevice(&dev);
    hipDeviceGetAttribute(&cus, hipDeviceAttributeMultiprocessorCount, dev);
    (void)hipOccupancyMaxActiveBlocksPerMultiprocessor(&per_cu, yoco_megakernel, 512, 0);
    if (per_cu > 1) per_cu = 1;
    grid_blocks = cus * per_cu;
  }
  (void)hipMemsetAsync(p.bar, 0, (size_t)XB_ALL_WORDS * 4, stream);
  void* args[] = {&p};
  hipError_t e = hipLaunchCooperativeKernel((void*)yoco_megakernel, dim3(grid_blocks), dim3(512), args, 0, stream);
  if (e != hipSuccess) fprintf(stderr, "cooperative launch failed: %s (grid %d)\n", hipGetErrorString(e), grid_blocks);
#endif
}
```

```cpp
#include <hip/hip_runtime.h>
#include <hip/hip_cooperative_groups.h>
#include <cstdio>
#include <cmath>
namespace cg = cooperative_groups;

#ifndef MULTI_LAUNCH
#define MULTI_LAUNCH 0
#endif

typedef unsigned short bf16;
typedef short bf16x8 __attribute__((ext_vector_type(8)));
typedef short s16x4 __attribute__((ext_vector_type(4)));
typedef float f32x16 __attribute__((ext_vector_type(16)));
typedef float f32x4 __attribute__((ext_vector_type(4)));
typedef unsigned u32x4 __attribute__((ext_vector_type(4)));
typedef unsigned u32x2 __attribute__((ext_vector_type(2)));
#define DI __device__ __forceinline__
#define MFMA32(a, b, c) __builtin_amdgcn_mfma_f32_32x32x16_bf16((a), (b), (c), 0, 0, 0)

constexpr int NTOK = 17408, NPR = 16384, DM = 1024;
constexpr float EPS = 1e-6f;
constexpr float LOG2E = 1.4426950408889634f;
constexpr size_t O_Y = 0, O_POOLP = 17825792, O_POOLS = 17837312, O_SKP = 19311872, O_SVP = 19344640,
                 O_SKS = 19377408, O_SVS = 23571712, O_MKP = 27766016, O_MVP = 27897088;

struct Params {
  const float *xp, *xs, *state_pool, *cswk, *cswv, *cmk, *cmv, *memp;
  const float *norm_a, *w_in_a, *pool_mix_w, *pool_scale, *w_out_a, *kv_norm, *w_kv, *k_norm, *norm_b, *w_in_b, *q_norm,
      *sinks, *w_out_b, *mem_norm, *w_mem_kv, *mem_q_norm, *mem_k_norm;
  float* out;
  bf16 *Wt_in_a, *Wt_out_a, *Wt_kvb, *Wt_out_b, *Wt_mem, *Wt_pool;
  bf16 *xb, *act, *z, *memb, *mkb, *dbuf;
  float *rstd_a, *rstd_mem, *ssq1;
  unsigned* bar;
  float rope_inv[8];
};

DI unsigned pack2(float a, float b) {
  typedef __bf16 bf2 __attribute__((ext_vector_type(2)));
  typedef float f2 __attribute__((ext_vector_type(2)));
  f2 f = {a, b};
  return __builtin_bit_cast(unsigned, __builtin_convertvector(f, bf2));
}
DI float bflo(unsigned u) { return __uint_as_float(u << 16); }
DI float bfhi(unsigned u) { return __uint_as_float(u & 0xffff0000u); }
DI float silu(float x) { return x * __builtin_amdgcn_rcpf(1.f + __builtin_amdgcn_exp2f(-LOG2E * x)); }
DI int crow(int i, int h) { return (i & 3) + 8 * (i >> 2) + 4 * h; }
DI const float* xrow(const Params& p, int tok) { return tok < NPR ? p.xp + (size_t)tok * DM : p.xs + (size_t)(tok - NPR) * DM; }

template <int MI, int NI>
DI void frag_read(u32x4 (&fa)[MI], u32x4 (&fb)[NI], unsigned ab, unsigned bb) {
  if constexpr (MI == 4 && NI == 2) {
    asm volatile("ds_read_b128 %0, %6\n\tds_read_b128 %1, %6 offset:2048\n\tds_read_b128 %2, %6 offset:4096\n\tds_read_b128 %3, %6 offset:6144\n\t"
                 "ds_read_b128 %4, %7\n\tds_read_b128 %5, %7 offset:2048"
                 : "=&v"(fa[0]), "=&v"(fa[1]), "=&v"(fa[2]), "=&v"(fa[3]), "=&v"(fb[0]), "=&v"(fb[1]) : "v"(ab), "v"(bb) : "memory");
  } else {
    static_assert((MI == 4 && NI == 2) || (MI == 2 && NI == 1), "tile config");
    asm volatile("ds_read_b128 %0, %3\n\tds_read_b128 %1, %3 offset:2048\n\tds_read_b128 %2, %4"
                 : "=&v"(fa[0]), "=&v"(fa[1]), "=&v"(fb[0]) : "v"(ab), "v"(bb) : "memory");
  }
}
template <int KEEP, int MI, int NI>
DI void frag_wait(u32x4 (&fa)[MI], u32x4 (&fb)[NI]) {
  if constexpr (MI == 4 && NI == 2)
    asm volatile("s_waitcnt lgkmcnt(%6)" : "+v"(fa[0]), "+v"(fa[1]), "+v"(fa[2]), "+v"(fa[3]), "+v"(fb[0]), "+v"(fb[1]) : "n"(KEEP) : "memory");
  else
    asm volatile("s_waitcnt lgkmcnt(%3)" : "+v"(fa[0]), "+v"(fa[1]), "+v"(fb[0]) : "n"(KEEP) : "memory");
}
template <int BM, int BN, class Epi>
DI void gemm_tile(const bf16* __restrict__ A, int lda, const bf16* __restrict__ Bt, int ldb, int nk64, int m0, int n0, char* smem, const Epi& epi) {
  constexpr int RW = BM / 2, CW = BN / 4, MI = RW / 32, NI = CW / 32;
  constexpr int A_BYTES = BM * 64, B_BYTES = BN * 64, STAGE = A_BYTES + B_BYTES, GA = BM / 128, GB = BN / 128, GT = GA + GB;
  const int nk = nk64 * 2;
  const int tid = threadIdx.x, lane = tid & 63, w = tid >> 6;
  const int wm = w >> 2, wn = w & 3, r = lane & 31, h = lane >> 5;
  f32x16 acc[MI][NI];
#pragma unroll
  for (int mi = 0; mi < MI; ++mi)
#pragma unroll
    for (int ni = 0; ni < NI; ++ni)
#pragma unroll
      for (int i = 0; i < 16; ++i) acc[mi][ni][i] = 0.f;
  const int srow = w * 16 + (lane >> 2);
  const int slc = (lane & 3) ^ ((srow >> 2) & 3);
  const bf16* Ag = A + (size_t)(m0 + srow) * lda + slc * 8;
  const bf16* Bg = Bt + (size_t)(n0 + srow) * ldb + slc * 8;
#define GEMM_STAGE(buf, kt)                                                                                                        \
  do {                                                                                                                             \
    char* sa_ = smem + (buf) * STAGE + w * 1024;                                                                                   \
    _Pragma("unroll") for (int i = 0; i < GA; ++i)                                                                                 \
        __builtin_amdgcn_global_load_lds((const unsigned*)(Ag + (size_t)(128 * i) * lda + (kt) * 32), (unsigned*)(sa_ + i * 8192), 16, 0, 0); \
    _Pragma("unroll") for (int i = 0; i < GB; ++i)                                                                                 \
        __builtin_amdgcn_global_load_lds((const unsigned*)(Bg + (size_t)(128 * i) * ldb + (kt) * 32), (unsigned*)(sa_ + A_BYTES + i * 8192), 16, 0, 0); \
  } while (0)
#define WAIT_V(n) asm volatile("s_waitcnt vmcnt(%0)" ::"n"(n) : "memory")
  asm volatile("s_waitcnt vmcnt(0)" ::: "memory");
  GEMM_STAGE(0, 0);
  GEMM_STAGE(1, 1);
  GEMM_STAGE(2, 2);
  int aoff[MI], boff[NI];
#pragma unroll
  for (int mi = 0; mi < MI; ++mi) { const int row = wm * RW + mi * 32 + r; aoff[mi] = row * 64 + ((h ^ ((row >> 2) & 3)) << 4); }
#pragma unroll
  for (int ni = 0; ni < NI; ++ni) { const int row = wn * CW + ni * 32 + r; boff[ni] = A_BYTES + row * 64 + ((h ^ ((row >> 2) & 3)) << 4); }
  constexpr int RD = MI + NI;
  const unsigned sb0 = (unsigned)(size_t)smem;
  u32x4 fa0[MI], fb0[NI], fa1[MI], fb1[NI];
#define GEMM_MMA(FA, FB)                                                                                   \
  _Pragma("unroll") for (int mi = 0; mi < MI; ++mi) _Pragma("unroll") for (int ni = 0; ni < NI; ++ni)      \
      acc[mi][ni] = MFMA32(__builtin_bit_cast(bf16x8, FB[ni]), __builtin_bit_cast(bf16x8, FA[mi]), acc[mi][ni])
  WAIT_V(2 * GT);
  __builtin_amdgcn_s_barrier();
  asm volatile("" ::: "memory");
  frag_read<MI, NI>(fa0, fb0, sb0 + (unsigned)aoff[0], sb0 + (unsigned)boff[0]);
#pragma unroll 1
  for (int kt = 0; kt < nk - 1; ++kt) {
    if (kt + 2 < nk) WAIT_V(GT); else WAIT_V(0);
    __builtin_amdgcn_s_barrier();
    asm volatile("" ::: "memory");
    if (kt + 3 < nk) GEMM_STAGE((kt + 3) & 3, kt + 3);
    const unsigned sc = sb0 + (unsigned)((kt & 3) * STAGE), sn = sb0 + (unsigned)(((kt + 1) & 3) * STAGE);
    frag_read<MI, NI>(fa1, fb1, (sc + (unsigned)aoff[0]) ^ 32u, (sc + (unsigned)boff[0]) ^ 32u);
    frag_wait<RD, MI, NI>(fa0, fb0);
    GEMM_MMA(fa0, fb0);
    frag_read<MI, NI>(fa0, fb0, sn + (unsigned)aoff[0], sn + (unsigned)boff[0]);
    frag_wait<RD, MI, NI>(fa1, fb1);
    GEMM_MMA(fa1, fb1);
  }
  {
    const unsigned sc = sb0 + (unsigned)(((nk - 1) & 3) * STAGE);
    frag_read<MI, NI>(fa1, fb1, (sc + (unsigned)aoff[0]) ^ 32u, (sc + (unsigned)boff[0]) ^ 32u);
    frag_wait<RD, MI, NI>(fa0, fb0);
    GEMM_MMA(fa0, fb0);
    frag_wait<0, MI, NI>(fa1, fb1);
    GEMM_MMA(fa1, fb1);
  }
#undef GEMM_MMA
#undef GEMM_STAGE
#undef WAIT_V
  __syncthreads();
  constexpr int CPB = (BN + 8) * 2, SEGS = BN / 32, ITEMS = BM * SEGS / 512;
#pragma unroll
  for (int mi = 0; mi < MI; ++mi)
#pragma unroll
    for (int ni = 0; ni < NI; ++ni)
#pragma unroll
      for (int g = 0; g < 4; ++g) {
        const int row = wm * RW + mi * 32 + r, col = wn * CW + ni * 32 + 8 * g + 4 * h;
        u32x2 pk = {pack2(acc[mi][ni][4 * g], acc[mi][ni][4 * g + 1]), pack2(acc[mi][ni][4 * g + 2], acc[mi][ni][4 * g + 3])};
        *(u32x2*)(smem + row * CPB + col * 2) = pk;
      }
  __syncthreads();
  typename Epi::Pre pre[ITEMS];
#pragma unroll
  for (int it = 0; it < ITEMS; ++it) {
    const int item = it * 512 + tid, prow = item / SEGS, seg = item % SEGS;
    epi.prefetch(m0 + prow, n0 + seg * 32, pre[it]);
  }
#pragma unroll
  for (int it = 0; it < ITEMS; ++it) {
    const int item = it * 512 + tid, prow = item / SEGS, seg = item % SEGS;
    float v[32];
#pragma unroll
    for (int j = 0; j < 4; ++j) {
      const u32x4 t = *(const u32x4*)(smem + prow * CPB + seg * 64 + 16 * j);
#pragma unroll
      for (int e = 0; e < 4; ++e) { v[8 * j + 2 * e] = bflo(t[e]); v[8 * j + 2 * e + 1] = bfhi(t[e]); }
    }
    epi(m0 + prow, n0 + seg * 32, v, pre[it]);
    if constexpr (Epi::LDS_OUT) {
#pragma unroll
      for (int j = 0; j < 4; ++j) {
        u32x4 o = {pack2(v[8 * j], v[8 * j + 1]), pack2(v[8 * j + 2], v[8 * j + 3]), pack2(v[8 * j + 4], v[8 * j + 5]), pack2(v[8 * j + 6], v[8 * j + 7])};
        *(u32x4*)(smem + prow * CPB + seg * 64 + 16 * j) = o;
      }
    }
  }
  __syncthreads();
  if constexpr (Epi::LDS_OUT) {
    constexpr int CH = BN / 8, NIT = BM * CH / 512;
    bf16* ob = epi.out_base() + (size_t)m0 * epi.out_ld() + n0;
    const int ld = epi.out_ld();
#pragma unroll 4
    for (int it = 0; it < NIT; ++it) {
      const int idx = it * 512 + tid, row = idx / CH, c8 = idx % CH;
      const u32x4 t = *(const u32x4*)(smem + row * CPB + c8 * 16);
      *(u32x4*)(ob + (size_t)row * ld + c8 * 8) = t;
    }
    __syncthreads();
  }
}
template <class Epi>
DI void gemm_phase(const bf16* A, int lda, const bf16* Bt, int ldb, int nk, int MT, int NT, char* smem, const Epi& epi, int g_vb) {
  const int nb = gridDim.x;
  const int vb = g_vb;
  const int U = MT * NT, full = (U / nb) * nb, rem = U - full;
#pragma unroll 1
  for (int u = vb; u < full; u += nb) gemm_tile<256, 256>(A, lda, Bt, ldb, nk, (u / NT) * 256, (u % NT) * 256, smem, epi);
  if (rem * 4 <= nb) {
    const int tvb = (nb & 255) == 0 ? ((vb & 31) * (nb >> 5) + (vb >> 5)) : vb;
#pragma unroll 1
    for (int sidx = tvb; sidx < rem * 4; sidx += nb) {
      const int u = full + (sidx >> 2), q = sidx & 3;
      gemm_tile<128, 128>(A, lda, Bt, ldb, nk, (u / NT) * 256 + (q >> 1) * 128, (u % NT) * 256 + (q & 1) * 128, smem, epi);
    }
  } else {
#pragma unroll 1
    for (int u = full + vb; u < U; u += nb) gemm_tile<256, 256>(A, lda, Bt, ldb, nk, (u / NT) * 256, (u % NT) * 256, smem, epi);
  }
}

template <int NC>
DI void store_bf16(bf16* dst, const float (&v)[NC]) {
#pragma unroll
  for (int j = 0; j < NC / 8; ++j) {
    u32x4 o = {pack2(v[8 * j], v[8 * j + 1]), pack2(v[8 * j + 2], v[8 * j + 3]), pack2(v[8 * j + 4], v[8 * j + 5]), pack2(v[8 * j + 6], v[8 * j + 7])};
    *(u32x4*)(dst + 8 * j) = o;
  }
}
template <int NC>
DI void store_f32(float* dst, const float (&v)[NC]) {
#pragma unroll
  for (int j = 0; j < NC / 4; ++j) { f32x4 o = {v[4 * j], v[4 * j + 1], v[4 * j + 2], v[4 * j + 3]}; *(f32x4*)(dst + 4 * j) = o; }
}
DI void head_rmsnorm(float (&v)[32], const float* gain, int hoff, float post) {
  float ss = 0.f;
#pragma unroll
  for (int j = 0; j < 32; ++j) ss += v[j] * v[j];
  ss += __shfl_xor(ss, 1);
  const float rs = rsqrtf(ss * (1.f / 64.f) + EPS) * post;
#pragma unroll
  for (int j = 0; j < 32; ++j) v[j] = v[j] * rs * gain[hoff + j];
}
DI void rope16(float (&v)[32], int pos, const float* inv) {
#pragma unroll
  for (int i = 0; i < 8; ++i) {
    double rev = (double)pos * (double)inv[i] * 0.15915494309189535;
    rev -= floor(rev);
    const float fr = (float)rev;
    const float sn = __builtin_amdgcn_sinf(fr), cs = __builtin_amdgcn_cosf(fr);
    const float a = v[i], b = v[i + 8];
    v[i] = a * cs - b * sn;
    v[i + 8] = b * cs + a * sn;
  }
}

struct EpiInA {
  static constexpr bool LDS_OUT = true;
  DI bf16* out_base() const { return p.z; }
  DI int out_ld() const { return 2048; }
  const Params& p;
  struct Pre { float rs; };
  DI void prefetch(int row, int col, Pre& q) const { q.rs = p.rstd_a[row]; }
  DI void operator()(int row, int col, float (&v)[32], const Pre& q) const {
    const float rs = q.rs;
#pragma unroll
    for (int j = 0; j < 32; ++j) v[j] *= rs;
    if (col < 768) {
      if (row >= NPR - 15) {
        if (row < NPR) store_f32<32>(p.out + O_POOLP + (size_t)(row - (NPR - 15)) * 768 + col, v);
        else { const int s = row - NPR, b = s >> 3, t = s & 7; store_f32<32>(p.out + O_POOLS + (size_t)(b * 15 + 7 + t) * 768 + col, v); }
      }
    } else if (col < 1536) {
#pragma unroll
      for (int j = 0; j < 32; ++j) v[j] = silu(v[j]);
    } else if (col < 1792) {
      head_rmsnorm(v, p.mem_q_norm, col & 63, 0.125f * LOG2E);
    } else {
#pragma unroll
      for (int j = 0; j < 32; ++j) v[j] = silu(v[j]);
    }
  }
};
struct EpiMemKV {
  static constexpr bool LDS_OUT = false;
  DI bf16* out_base() const { return nullptr; }
  DI int out_ld() const { return 0; }
  const Params& p;
  struct Pre { float rs; };
  DI void prefetch(int row, int col, Pre& q) const { q.rs = p.rstd_mem[row]; }
  DI void operator()(int row, int col, float (&v)[32], const Pre& q) const {
    const float rs = q.rs;
#pragma unroll
    for (int j = 0; j < 32; ++j) v[j] *= rs;
    const int l = col >> 9, wi = col & 511;
    const bool isk = wi < 256;
    if (isk) head_rmsnorm(v, p.mem_k_norm + l * 64, col & 63, 1.f);
    const size_t e = (size_t)(l * 256 + row) * 256 + (wi & 255) + (isk ? 0 : 131072);
    store_f32<32>(p.out + O_MKP + e, v);
    store_bf16<32>(p.mkb + e, v);
  }
};
struct EpiPool {
  static constexpr bool LDS_OUT = false;
  DI bf16* out_base() const { return nullptr; }
  DI int out_ld() const { return 0; }
  const Params& p;
  struct Pre { u32x4 g[4]; };
  DI void prefetch(int row, int col, Pre& pq) const {
    const bf16* gp = p.z + (size_t)row * 2048 + 768 + col;
#pragma unroll
    for (int q = 0; q < 4; ++q) pq.g[q] = *(const u32x4*)(gp + 8 * q);
  }
  DI void operator()(int row, int col, float (&v)[32], const Pre& pq) const {
    const float* sc = p.pool_scale + col;
#pragma unroll
    for (int q = 0; q < 4; ++q) {
      const u32x4 g = pq.g[q];
#pragma unroll
      for (int j = 0; j < 4; ++j) { v[8 * q + 2 * j] *= sc[8 * q + 2 * j] * bflo(g[j]); v[8 * q + 2 * j + 1] *= sc[8 * q + 2 * j + 1] * bfhi(g[j]); }
    }
    store_bf16<32>(p.act + (size_t)row * 1024 + col, v);
  }
};
struct EpiOutA {
  static constexpr bool LDS_OUT = false;
  DI bf16* out_base() const { return nullptr; }
  DI int out_ld() const { return 0; }
  const Params& p;
  struct Pre { u32x4 x[4]; };
  DI void prefetch(int row, int col, Pre& q) const {
    const bf16* xr = p.xb + (size_t)row * 1024 + col;
#pragma unroll
    for (int j = 0; j < 4; ++j) q.x[j] = *(const u32x4*)(xr + 8 * j);
  }
  DI void operator()(int row, int col, float (&v)[32], const Pre& q) const {
    float ss = 0.f;
#pragma unroll
    for (int j = 0; j < 4; ++j)
#pragma unroll
      for (int e = 0; e < 4; ++e) { v[8 * j + 2 * e] += bflo(q.x[j][e]); v[8 * j + 2 * e + 1] += bfhi(q.x[j][e]); }
#pragma unroll
    for (int j = 0; j < 32; ++j) ss += v[j] * v[j];
    ss += __shfl_xor(ss, 1);
    ss += __shfl_xor(ss, 2);
    if ((threadIdx.x & 3) == 0) atomicAdd(p.ssq1 + row, ss);
    store_bf16<32>(p.xb + (size_t)row * 1024 + col, v);
  }
};
struct EpiKVB {
  static constexpr bool LDS_OUT = true;
  DI bf16* out_base() const { return p.z; }
  DI int out_ld() const { return 2560; }
  const Params& p;
  struct Pre { float ssq; };
  DI void prefetch(int row, int col, Pre& q) const { q.ssq = p.ssq1[row]; }
  DI void operator()(int row, int col, float (&v)[32], const Pre& q) const {
    const float rs = rsqrtf(q.ssq * (1.f / 1024.f) + EPS);
#pragma unroll
    for (int j = 0; j < 32; ++j) v[j] *= rs;
    const int pos = row < NPR ? row : NPR + ((row - NPR) & 7);
    if (col < 512) {
      if (col < 256) {
        head_rmsnorm(v, p.k_norm, col & 63, 1.f);
        if ((col & 63) == 0) rope16(v, pos, p.rope_inv);
      }
      const size_t ob = col < 256 ? 0 : (O_SVP - O_SKP);
      const size_t obs = col < 256 ? 0 : (O_SVS - O_SKS);
      const int c = col & 255;
      if (row >= NPR - 128) {
        if (row < NPR) store_f32<32>(p.out + O_SKP + ob + (size_t)(row - (NPR - 128)) * 256 + c, v);
        else { const int s = row - NPR, b = s >> 3, t = s & 7; store_f32<32>(p.out + O_SKS + obs + (size_t)(b * 128 + 120 + t) * 256 + c, v); }
      }
    } else if (col < 1280) {
      head_rmsnorm(v, p.q_norm, col & 63, 0.125f * LOG2E);
      if ((col & 63) == 0) rope16(v, pos, p.rope_inv);
    } else if (col < 2048) {
#pragma unroll
      for (int j = 0; j < 32; ++j) v[j] = silu(v[j]);
    } else if (col < 2304) {
      head_rmsnorm(v, p.mem_q_norm + 64, col & 63, 0.125f * LOG2E);
    } else {
#pragma unroll
      for (int j = 0; j < 32; ++j) v[j] = silu(v[j]);
    }
  }
};
struct EpiOutB {
  static constexpr bool LDS_OUT = false;
  DI bf16* out_base() const { return nullptr; }
  DI int out_ld() const { return 0; }
  const Params& p;
  struct Pre { u32x4 x[4]; };
  DI void prefetch(int row, int col, Pre& q) const {
    const bf16* xr = p.xb + (size_t)row * 1024 + col;
#pragma unroll
    for (int j = 0; j < 4; ++j) q.x[j] = *(const u32x4*)(xr + 8 * j);
  }
  DI void operator()(int row, int col, float (&v)[32], const Pre& q) const {
#pragma unroll
    for (int j = 0; j < 4; ++j)
#pragma unroll
      for (int e = 0; e < 4; ++e) { v[8 * j + 2 * e] += bflo(q.x[j][e]); v[8 * j + 2 * e + 1] += bfhi(q.x[j][e]); }
    store_f32<32>(p.out + O_Y + (size_t)row * 1024 + col, v);
  }
};

template <bool MASKED>
DI void attn_chunk(const bf16x8 (&qf)[4], const char* kimg, const char* vimg, float& m, float& l, f32x16 (&o)[2], int lane, int lo, int hi) {
  const int r = lane & 31, h = lane >> 5;
  f32x16 s[2];
#pragma unroll
  for (int kt = 0; kt < 2; ++kt) {
#pragma unroll
    for (int i = 0; i < 16; ++i) s[kt][i] = 0.f;
#pragma unroll
    for (int ks = 0; ks < 4; ++ks) {
      const int row = kt * 32 + r, chunk = ks * 2 + h;
      const bf16x8 kf = *(const bf16x8*)(kimg + row * 128 + ((chunk ^ ((row >> 1) & 7)) << 4));
      s[kt] = MFMA32(kf, qf[ks], s[kt]);
    }
  }
  float mx = -1e30f;
#pragma unroll
  for (int kt = 0; kt < 2; ++kt)
#pragma unroll
    for (int i = 0; i < 16; ++i) {
      if (MASKED) {
        const int kk = kt * 32 + crow(i, h);
        const bool ok = (kk >= lo) && (kk <= hi);
        s[kt][i] = ok ? s[kt][i] : -1e30f;
      }
      mx = fmaxf(mx, s[kt][i]);
    }
  mx = fmaxf(mx, __shfl_xor(mx, 32));
  const float mn = fmaxf(m, mx);
  const float alpha = __builtin_amdgcn_exp2f(m - mn);
  m = mn;
  float ps = 0.f;
#pragma unroll
  for (int kt = 0; kt < 2; ++kt)
#pragma unroll
    for (int i = 0; i < 16; ++i) {
      const float pv = (!MASKED || s[kt][i] > -1e29f) ? __builtin_amdgcn_exp2f(s[kt][i] - mn) : 0.f;
      s[kt][i] = pv;
      ps += pv;
    }
  l = l * alpha + ps;
#pragma unroll
  for (int dt = 0; dt < 2; ++dt)
#pragma unroll
    for (int i = 0; i < 16; ++i) o[dt][i] *= alpha;
  const int i16 = lane & 15, q = i16 >> 2, pp = i16 & 3, blk = (lane >> 4) & 1;
#pragma unroll
  for (int kt = 0; kt < 2; ++kt)
#pragma unroll
    for (int st = 0; st < 2; ++st) {
      u32x4 pk = {pack2(s[kt][8 * st], s[kt][8 * st + 1]), pack2(s[kt][8 * st + 2], s[kt][8 * st + 3]),
                  pack2(s[kt][8 * st + 4], s[kt][8 * st + 5]), pack2(s[kt][8 * st + 6], s[kt][8 * st + 7])};
      const bf16x8 pf = __builtin_bit_cast(bf16x8, pk);
      const int row = kt * 32 + st * 16 + 4 * h + q;
#pragma unroll
      for (int dt = 0; dt < 2; ++dt) {
        const int cb = (dt * 32 + blk * 16 + pp * 4) * 2;
        const int a0 = row * 128 + (cb ^ (((row >> 1) & 1) << 6));
        const s16x4 lo4 = __builtin_amdgcn_ds_read_tr16_b64_v4i16((s16x4 __attribute__((address_space(3)))*)(vimg + a0));
        const s16x4 hi4 = __builtin_amdgcn_ds_read_tr16_b64_v4i16((s16x4 __attribute__((address_space(3)))*)(vimg + a0 + 8 * 128));
        const bf16x8 vf = __builtin_shufflevector(lo4, hi4, 0, 1, 2, 3, 4, 5, 6, 7);
        o[dt] = MFMA32(vf, pf, o[dt]);
      }
    }
}
DI void attn_store(const f32x16 (&o)[2], float l, int lane, bool valid, bf16* dst, const bf16* gate) {
  const int h = lane >> 5;
  const float lt = l + __shfl_xor(l, 32);
  const float inv = 1.f / lt;
  if (valid) {
#pragma unroll
    for (int dt = 0; dt < 2; ++dt)
#pragma unroll
      for (int g4 = 0; g4 < 4; ++g4) {
        const int d0 = dt * 32 + g4 * 8 + 4 * h;
        const u32x2 gg = *(const u32x2*)(gate + d0);
        u32x2 ov = {pack2(o[dt][4 * g4] * inv * bflo(gg[0]), o[dt][4 * g4 + 1] * inv * bfhi(gg[0])),
                    pack2(o[dt][4 * g4 + 2] * inv * bflo(gg[1]), o[dt][4 * g4 + 3] * inv * bfhi(gg[1]))};
        *(u32x2*)(dst + d0) = ov;
      }
  }
}
DI void attn_store_rows(const f32x16 (&o)[2], float l, int lane, char* slab, bf16* dst0, const bf16* gate0, int ldg) {
  const int r = lane & 31, h = lane >> 5;
  const float lt = l + __shfl_xor(l, 32);
  const float inv = 1.f / lt;
#pragma unroll
  for (int dt = 0; dt < 2; ++dt)
#pragma unroll
    for (int g4 = 0; g4 < 4; ++g4) {
      const int d0 = dt * 32 + g4 * 8 + 4 * h;
      u32x2 ov = {pack2(o[dt][4 * g4] * inv, o[dt][4 * g4 + 1] * inv), pack2(o[dt][4 * g4 + 2] * inv, o[dt][4 * g4 + 3] * inv)};
      *(u32x2*)(slab + r * 144 + d0 * 2) = ov;
    }
  asm volatile("s_waitcnt lgkmcnt(0)" ::: "memory");
#pragma unroll
  for (int i = 0; i < 4; ++i) {
    const int row = i * 8 + (lane >> 3), c8 = lane & 7;
    const u32x4 t = *(const u32x4*)(slab + row * 144 + c8 * 16);
    const u32x4 g = *(const u32x4*)(gate0 + (size_t)row * ldg + c8 * 8);
    u32x4 ov;
#pragma unroll
    for (int e = 0; e < 4; ++e) ov[e] = pack2(bflo(t[e]) * bflo(g[e]), bfhi(t[e]) * bfhi(g[e]));
    *(u32x4*)(dst0 + (size_t)row * 1024 + c8 * 8) = ov;
  }
  asm volatile("s_waitcnt lgkmcnt(0)" ::: "memory");
}
DI void load_q(bf16x8 (&qf)[4], const bf16* qrow, int h) {
#pragma unroll
  for (int ks = 0; ks < 4; ++ks) qf[ks] = *(const bf16x8*)(qrow + ks * 16 + 8 * h);
}
template <int NROWS>
DI void stage_bf16(char* img, const bf16* src, int ld, bool vimg, int zero_below) {
  const int tid = threadIdx.x;
#pragma unroll
  for (int i = 0; i < NROWS / 64; ++i) {
    const int id = tid + 512 * i, row = id >> 3, kc = id & 7;
    u32x4 t = {0u, 0u, 0u, 0u};
    if (row >= zero_below) t = *(const u32x4*)(src + (ptrdiff_t)row * ld + kc * 8);
    const int sw = vimg ? (kc ^ (((row >> 1) & 1) << 2)) : (kc ^ ((row >> 1) & 7));
    *(u32x4*)(img + row * 128 + (sw << 4)) = t;
  }
}

DI void mem_attn_prompt(const Params& p, int layer, int unit, char* smem) {
  const int tt = unit >> 2, hh = unit & 3;
  const int lane = threadIdx.x & 63, w = threadIdx.x >> 6, r = lane & 31, h = lane >> 5;
  const int ldz = layer ? 2560 : 2048, qcol = layer ? 2048 : 1536, gcol = layer ? 2304 : 1792;
  char* kimg = smem; char* vimg = smem + 32768;
  stage_bf16<256>(kimg, p.mkb + (size_t)layer * 65536 + hh * 64, 256, false, 0);
  stage_bf16<256>(vimg, p.mkb + 131072 + (size_t)layer * 65536 + hh * 64, 256, true, 0);
  const int tok = tt * 256 + w * 32 + r;
  bf16x8 qf[4];
  load_q(qf, p.z + (size_t)tok * ldz + qcol + hh * 64, h);
  __syncthreads();
  float m = -1e30f, l = 0.f;
  f32x16 o[2];
#pragma unroll
  for (int dt = 0; dt < 2; ++dt)
#pragma unroll
    for (int i = 0; i < 16; ++i) o[dt][i] = 0.f;
#pragma unroll 1
  for (int c = 0; c < 4; ++c) attn_chunk<false>(qf, kimg + c * 8192, vimg + c * 8192, m, l, o, lane, 0, 63);
  {
    const int tok0 = tt * 256 + w * 32;
    attn_store_rows(o, l, lane, smem + 98304 + w * 4608, p.act + (size_t)tok0 * 1024 + 768 + hh * 64, p.z + (size_t)tok0 * ldz + gcol + hh * 64, ldz);
  }
  __syncthreads();
}
DI void swa_prompt(const Params& p, int unit, char* smem) {
  const int n = unit >> 2, kvh = unit & 3;
  const int lane = threadIdx.x & 63, w = threadIdx.x >> 6, r = lane & 31, h = lane >> 5;
  char* kimg = smem; char* vimg = smem + 49152;
  const bf16* kv0 = p.z + (ptrdiff_t)(n * 256 - 128) * 2560 + kvh * 64;
  const int zb = n == 0 ? 128 : 0;
  stage_bf16<384>(kimg, kv0, 2560, false, zb);
  stage_bf16<384>(vimg, kv0 + 256, 2560, true, zb);
  __syncthreads();
  const int t = w * 32 + r, tok = n * 256 + t;
  const int klo = (n == 0 && t + 1 < 128) ? 128 : t + 1, khi = t + 128;
  const int c0 = (32 * w + 1) >> 6, c1 = (32 * w + 159) >> 6;
#pragma unroll 1
  for (int g = 0; g < 3; ++g) {
    const int head = kvh * 3 + g;
    bf16x8 qf[4];
    load_q(qf, p.z + (size_t)tok * 2560 + 512 + head * 64, h);
    float m = p.sinks[head] * LOG2E, l = h == 0 ? 1.f : 0.f;
    f32x16 o[2];
#pragma unroll
    for (int dt = 0; dt < 2; ++dt)
#pragma unroll
      for (int i = 0; i < 16; ++i) o[dt][i] = 0.f;
#pragma unroll 1
    for (int c = c0; c <= c1; ++c) attn_chunk<true>(qf, kimg + c * 8192, vimg + c * 8192, m, l, o, lane, klo - 64 * c, khi - 64 * c);
    attn_store_rows(o, l, lane, smem + 98304 + w * 4608, p.act + (size_t)(n * 256 + w * 32) * 1024 + head * 64, p.z + (size_t)(n * 256 + w * 32) * 2560 + 1280 + head * 64, 2560);
  }
  __syncthreads();
}
template <bool SWA>
DI void stage_wave_kv(char* kimg, char* vimg, const float* ksrc, const float* vsrc, int key0, int nvalid, const bf16* extra, int nextra, int head,
                      float* kcopy, float* vcopy, int lane) {
  f32x4 ka[8], kb[8], va[8], vb[8];
#pragma unroll
  for (int i = 0; i < 8; ++i) {
    const int id = lane + 64 * i, key = id >> 3, kc = id & 7, kk = key0 + key;
    ka[i] = kb[i] = va[i] = vb[i] = (f32x4){0.f, 0.f, 0.f, 0.f};
    if (kk < nvalid) {
      const size_t o = (size_t)kk * 256 + head * 64 + kc * 8;
      ka[i] = *(const f32x4*)(ksrc + o); kb[i] = *(const f32x4*)(ksrc + o + 4);
      va[i] = *(const f32x4*)(vsrc + o); vb[i] = *(const f32x4*)(vsrc + o + 4);
    } else if (SWA && kk - nvalid < nextra) {
      const bf16* e = extra + (size_t)(kk - nvalid) * 2560 + head * 64 + kc * 8;
      ka[i] = __builtin_bit_cast(f32x4, *(const u32x4*)e); va[i] = __builtin_bit_cast(f32x4, *(const u32x4*)(e + 256));
    }
  }
#pragma unroll
  for (int i = 0; i < 8; ++i) {
    const int id = lane + 64 * i, key = id >> 3, kc = id & 7, kk = key0 + key;
    u32x4 tk = __builtin_bit_cast(u32x4, ka[i]), tv = __builtin_bit_cast(u32x4, va[i]);
    if (kk < nvalid) {
      if (SWA && kk >= 8) {
        const size_t o = (size_t)(kk - 8) * 256 + head * 64 + kc * 8;
        *(f32x4*)(kcopy + o) = ka[i]; *(f32x4*)(kcopy + o + 4) = kb[i];
        *(f32x4*)(vcopy + o) = va[i]; *(f32x4*)(vcopy + o + 4) = vb[i];
      }
      tk = (u32x4){pack2(ka[i][0], ka[i][1]), pack2(ka[i][2], ka[i][3]), pack2(kb[i][0], kb[i][1]), pack2(kb[i][2], kb[i][3])};
      tv = (u32x4){pack2(va[i][0], va[i][1]), pack2(va[i][2], va[i][3]), pack2(vb[i][0], vb[i][1]), pack2(vb[i][2], vb[i][3])};
    }
    *(u32x4*)(kimg + key * 128 + ((kc ^ ((key >> 1) & 7)) << 4)) = tk;
    *(u32x4*)(vimg + key * 128 + ((kc ^ (((key >> 1) & 1) << 2)) << 4)) = tv;
  }
}
template <bool SWA>
DI void decode_unit(const Params& p, int layer, int unit, char* smem) {
  const int tid = threadIdx.x, lane = tid & 63, w = tid >> 6, r = lane & 31, h = lane >> 5;
  const int b = unit >> 1, hd = (unit & 1) * 2 + (w >> 2), c = w & 3;
  const int ldz = (SWA || layer) ? 2560 : 2048;
  char* kimg = smem + w * 16384; char* vimg = kimg + 8192;
  const int t = r & 7, g = SWA ? ((r >> 3) > 2 ? 2 : (r >> 3)) : 0;
  const int qhead = SWA ? hd * 3 + g : hd;
  const int qcol = SWA ? 512 : (layer ? 2048 : 1536);
  const int tok = NPR + b * 8 + t;
  bf16x8 qf[4];
  load_q(qf, p.z + (size_t)tok * ldz + qcol + qhead * 64, h);
  const bool active = SWA ? (c < 3) : true;
  if (active) {
    if (SWA) {
      const bf16* knew = p.z + (size_t)(NPR + b * 8) * 2560;
      stage_wave_kv<true>(kimg, vimg, p.cswk + (size_t)b * 32768, p.cswv + (size_t)b * 32768, c * 64, 128, knew, 8, hd,
                          p.out + O_SKS + (size_t)b * 32768, p.out + O_SVS + (size_t)b * 32768, lane);
    } else {
      stage_wave_kv<false>(kimg, vimg, p.cmk + ((size_t)layer * 128 + b) * 65536, p.cmv + ((size_t)layer * 128 + b) * 65536, c * 64, 256, nullptr, 0, hd,
                           nullptr, nullptr, lane);
    }
  }
  __syncthreads();
  float m = -1e30f, l = 0.f;
  if (SWA && c == 0) { m = p.sinks[qhead] * LOG2E; l = h == 0 ? 1.f : 0.f; }
  f32x16 o[2];
#pragma unroll
  for (int dt = 0; dt < 2; ++dt)
#pragma unroll
    for (int i = 0; i < 16; ++i) o[dt][i] = 0.f;
  if (active) attn_chunk<SWA>(qf, kimg, vimg, m, l, o, lane, SWA ? t + 1 - 64 * c : 0, SWA ? t + 128 - 64 * c : 63);
  __syncthreads();
  float* R = (float*)(smem + w * 16384);
  const float lt = l + __shfl_xor(l, 32);
#pragma unroll
  for (int dt = 0; dt < 2; ++dt)
#pragma unroll
    for (int i = 0; i < 16; ++i) R[(dt * 32 + crow(i, h)) * 32 + r] = o[dt][i];
  if (h == 0) { R[2048 + r] = m; R[2080 + r] = lt; }
  __syncthreads();
  const int head2 = tid >> 8, slot = (tid & 255) >> 3, dg = tid & 7;
  if (slot < (SWA ? 24 : 8)) {
    float mc[4], lc[4], M = -1e30f;
#pragma unroll
    for (int cc = 0; cc < 4; ++cc) {
      const float* Rc = (const float*)(smem + (head2 * 4 + cc) * 16384);
      mc[cc] = Rc[2048 + slot]; lc[cc] = Rc[2080 + slot];
      M = fmaxf(M, mc[cc]);
    }
    float L = 0.f, a8[8];
#pragma unroll
    for (int e = 0; e < 8; ++e) a8[e] = 0.f;
#pragma unroll
    for (int cc = 0; cc < 4; ++cc) {
      const float* Rc = (const float*)(smem + (head2 * 4 + cc) * 16384);
      const float wgt = __builtin_amdgcn_exp2f(mc[cc] - M);
      L += wgt * lc[cc];
#pragma unroll
      for (int e = 0; e < 8; ++e) a8[e] += wgt * Rc[(dg * 8 + e) * 32 + slot];
    }
    const float inv = 1.f / L;
    const int hd2 = (unit & 1) * 2 + head2, t2 = slot & 7, g2 = slot >> 3;
    const int tok2 = NPR + b * 8 + t2;
    const int ocol = SWA ? (hd2 * 3 + g2) * 64 : 768 + hd2 * 64;
    const int gcol = SWA ? 1280 + (hd2 * 3 + g2) * 64 : (layer ? 2304 : 1792) + hd2 * 64;
    const u32x4 gg = *(const u32x4*)(p.z + (size_t)tok2 * ldz + gcol + dg * 8);
    u32x4 ov;
#pragma unroll
    for (int e = 0; e < 4; ++e) ov[e] = pack2(a8[2 * e] * inv * bflo(gg[e]), a8[2 * e + 1] * inv * bfhi(gg[e]));
    *(u32x4*)(p.act + (size_t)tok2 * 1024 + ocol + dg * 8) = ov;
  }
  __syncthreads();
}
DI void kv_load(f32x4 (&ka)[8], f32x4 (&kb)[8], f32x4 (&va)[8], f32x4 (&vb)[8], const float* ksrc, const float* vsrc, int key0, int head, int lane) {
#pragma unroll
  for (int i = 0; i < 8; ++i) {
    const int id = lane + 64 * i, key = id >> 3, kc = id & 7;
    const size_t o = (size_t)(key0 + key) * 256 + head * 64 + kc * 8;
    ka[i] = *(const f32x4*)(ksrc + o); kb[i] = *(const f32x4*)(ksrc + o + 4);
    va[i] = *(const f32x4*)(vsrc + o); vb[i] = *(const f32x4*)(vsrc + o + 4);
  }
}
DI void kv_store(const f32x4 (&ka)[8], const f32x4 (&kb)[8], const f32x4 (&va)[8], const f32x4 (&vb)[8], char* kimg, char* vimg, int lane) {
#pragma unroll
  for (int i = 0; i < 8; ++i) {
    const int id = lane + 64 * i, key = id >> 3, kc = id & 7;
    const u32x4 tk = {pack2(ka[i][0], ka[i][1]), pack2(ka[i][2], ka[i][3]), pack2(kb[i][0], kb[i][1]), pack2(kb[i][2], kb[i][3])};
    const u32x4 tv = {pack2(va[i][0], va[i][1]), pack2(va[i][2], va[i][3]), pack2(vb[i][0], vb[i][1]), pack2(vb[i][2], vb[i][3])};
    *(u32x4*)(kimg + key * 128 + ((kc ^ ((key >> 1) & 7)) << 4)) = tk;
    *(u32x4*)(vimg + key * 128 + ((kc ^ (((key >> 1) & 1) << 2)) << 4)) = tv;
  }
}
DI void decode_mem_loop(const Params& p, int layer, int u0, int ustep, char* smem) {
  const int tid = threadIdx.x, lane = tid & 63, w = tid >> 6, r = lane & 31, h = lane >> 5;
  const int c = w & 3;
  const int ldz = layer ? 2560 : 2048;
  char* kimg = smem + w * 16384; char* vimg = kimg + 8192;
  f32x4 ka[8], kb[8], va[8], vb[8];
  if (u0 < 256) {
    const int b0 = u0 >> 1, hd0 = (u0 & 1) * 2 + (w >> 2);
    kv_load(ka, kb, va, vb, p.cmk + ((size_t)layer * 128 + b0) * 65536, p.cmv + ((size_t)layer * 128 + b0) * 65536, c * 64, hd0, lane);
  }
#pragma unroll 1
  for (int unit = u0; unit < 256; unit += ustep) {
    const int b = unit >> 1, hd = (unit & 1) * 2 + (w >> 2);
    const int t = r & 7;
    const int qhead = hd;
    const int qcol = layer ? 2048 : 1536;
    const int tok = NPR + b * 8 + t;
    bf16x8 qf[4];
    load_q(qf, p.z + (size_t)tok * ldz + qcol + qhead * 64, h);
    const bool active = true;
    kv_store(ka, kb, va, vb, kimg, vimg, lane);
    __syncthreads();
    {
      const int un = unit + ustep;
      if (un < 256) {
        const int bn = un >> 1, hdn = (un & 1) * 2 + (w >> 2);
        kv_load(ka, kb, va, vb, p.cmk + ((size_t)layer * 128 + bn) * 65536, p.cmv + ((size_t)layer * 128 + bn) * 65536, c * 64, hdn, lane);
      }
    }
    float m = -1e30f, l = 0.f;
    if (false && c == 0) { m = p.sinks[qhead] * LOG2E; l = h == 0 ? 1.f : 0.f; }
    f32x16 o[2];
  #pragma unroll
    for (int dt = 0; dt < 2; ++dt)
  #pragma unroll
      for (int i = 0; i < 16; ++i) o[dt][i] = 0.f;
    if (active) attn_chunk<false>(qf, kimg, vimg, m, l, o, lane, false ? t + 1 - 64 * c : 0, false ? t + 128 - 64 * c : 63);
    __syncthreads();
    float* R = (float*)(smem + w * 16384);
    const float lt = l + __shfl_xor(l, 32);
  #pragma unroll
    for (int dt = 0; dt < 2; ++dt)
  #pragma unroll
      for (int i = 0; i < 16; ++i) R[(dt * 32 + crow(i, h)) * 32 + r] = o[dt][i];
    if (h == 0) { R[2048 + r] = m; R[2080 + r] = lt; }
    __syncthreads();
    const int head2 = tid >> 8, slot = (tid & 255) >> 3, dg = tid & 7;
    if (slot < (false ? 24 : 8)) {
      float mc[4], lc[4], M = -1e30f;
  #pragma unroll
      for (int cc = 0; cc < 4; ++cc) {
        const float* Rc = (const float*)(smem + (head2 * 4 + cc) * 16384);
        mc[cc] = Rc[2048 + slot]; lc[cc] = Rc[2080 + slot];
        M = fmaxf(M, mc[cc]);
      }
      float L = 0.f, a8[8];
  #pragma unroll
      for (int e = 0; e < 8; ++e) a8[e] = 0.f;
  #pragma unroll
      for (int cc = 0; cc < 4; ++cc) {
        const float* Rc = (const float*)(smem + (head2 * 4 + cc) * 16384);
        const float wgt = __builtin_amdgcn_exp2f(mc[cc] - M);
        L += wgt * lc[cc];
  #pragma unroll
        for (int e = 0; e < 8; ++e) a8[e] += wgt * Rc[(dg * 8 + e) * 32 + slot];
      }
      const float inv = 1.f / L;
      const int hd2 = (unit & 1) * 2 + head2, t2 = slot & 7, g2 = slot >> 3;
      const int tok2 = NPR + b * 8 + t2;
      const int ocol = false ? (hd2 * 3 + g2) * 64 : 768 + hd2 * 64;
      const int gcol = false ? 1280 + (hd2 * 3 + g2) * 64 : (layer ? 2304 : 1792) + hd2 * 64;
      const u32x4 gg = *(const u32x4*)(p.z + (size_t)tok2 * ldz + gcol + dg * 8);
      u32x4 ov;
  #pragma unroll
      for (int e = 0; e < 4; ++e) ov[e] = pack2(a8[2 * e] * inv * bflo(gg[e]), a8[2 * e + 1] * inv * bfhi(gg[e]));
      *(u32x4*)(p.act + (size_t)tok2 * 1024 + ocol + dg * 8) = ov;
    }
    __syncthreads();
  }
}
template <int W>
DI void pool_d_item(const Params& p, int tok, int c0, bf16* __restrict__ dbuf) {
  const bf16* __restrict__ zz = p.z;
  float a[8];
#pragma unroll
  for (int j = 0; j < 8; ++j) a[j] = 0.f;
  u32x4 u0 = {0u, 0u, 0u, 0u};
  float cnt;
  if (tok < NPR) {
    const int nr = tok + 1 < W ? tok + 1 : W;
    cnt = (float)nr;
    u32x4 t[W];
#pragma unroll
    for (int j = 0; j < W; ++j) { const int rr = tok - j < 0 ? 0 : tok - j; t[j] = *(const u32x4*)(zz + (size_t)rr * 2048 + c0); }
    u0 = t[0];
#pragma unroll
    for (int j = 0; j < W; ++j) {
      const float vm = j < nr ? 1.f : 0.f;
#pragma unroll
      for (int e = 0; e < 4; ++e) { a[2 * e] += vm * bflo(t[j][e]); a[2 * e + 1] += vm * bfhi(t[j][e]); }
    }
  } else {
    const int s = tok - NPR, b = s >> 3, t8 = s & 7;
    cnt = (float)W;
    u0 = *(const u32x4*)(zz + (size_t)tok * 2048 + c0);
#pragma unroll
    for (int j = 0; j < W; ++j) {
      const int tt = t8 - j;
      if (tt >= 0) {
        const u32x4 t = *(const u32x4*)(zz + (size_t)(tok - j) * 2048 + c0);
#pragma unroll
        for (int e = 0; e < 4; ++e) { a[2 * e] += bflo(t[e]); a[2 * e + 1] += bfhi(t[e]); }
      } else {
        const float* sp = p.state_pool + (size_t)(b * 15 + 15 + tt) * 768 + c0;
        const f32x4 x0 = *(const f32x4*)sp, x1 = *(const f32x4*)(sp + 4);
        a[0] += x0[0]; a[1] += x0[1]; a[2] += x0[2]; a[3] += x0[3]; a[4] += x1[0]; a[5] += x1[1]; a[6] += x1[2]; a[7] += x1[3];
      }
    }
  }
  const float ic = 1.f / cnt;
  u32x4 o;
#pragma unroll
  for (int e = 0; e < 4; ++e) o[e] = pack2(a[2 * e] * ic - bflo(u0[e]), a[2 * e + 1] * ic - bfhi(u0[e]));
  *(u32x4*)(dbuf + (size_t)tok * 768 + c0) = o;
}

DI void transpose_tile(const float* src, int K, int N, const float* gain, bf16* dst, int tile, char* smem, bool valid) {
  const int tid = threadIdx.x & 255;
  float* T = (float*)(smem + (threadIdx.x >> 8) * 16640);
  const int ntn = N >> 6, k0 = (tile / ntn) << 6, n0 = (tile % ntn) << 6;
  const int c4 = tid & 15, ri = tid >> 4;
  if (valid) {
#pragma unroll
    for (int i = 0; i < 4; ++i) {
      const int k = ri + 16 * i;
      f32x4 t = *(const f32x4*)(src + (size_t)(k0 + k) * N + n0 + c4 * 4);
      const float gsc = gain ? gain[k0 + k] : 1.f;
      T[k * 65 + c4 * 4] = t[0] * gsc; T[k * 65 + c4 * 4 + 1] = t[1] * gsc; T[k * 65 + c4 * 4 + 2] = t[2] * gsc; T[k * 65 + c4 * 4 + 3] = t[3] * gsc;
    }
  }
  __syncthreads();
  const int k8 = tid & 7, nn = tid >> 3;
  if (valid) {
#pragma unroll
    for (int i = 0; i < 2; ++i) {
      const int n = nn + 32 * i;
      const float* tp = T + (k8 * 8) * 65 + n;
      u32x4 o = {pack2(tp[0], tp[65]), pack2(tp[130], tp[195]), pack2(tp[260], tp[325]), pack2(tp[390], tp[455])};
      *(u32x4*)(dst + (size_t)(n0 + n) * K + k0 + k8 * 8) = o;
    }
  }
  __syncthreads();
}
DI void row_prep(const float* src, bf16* dst, float* rstd, int lane) {
  float ss = 0.f;
  f32x4 t[4];
#pragma unroll
  for (int i = 0; i < 4; ++i) { t[i] = *(const f32x4*)(src + i * 256 + lane * 4); ss += t[i][0] * t[i][0] + t[i][1] * t[i][1] + t[i][2] * t[i][2] + t[i][3] * t[i][3]; }
#pragma unroll
  for (int o = 32; o > 0; o >>= 1) ss += __shfl_xor(ss, o);
#pragma unroll
  for (int i = 0; i < 4; ++i) { u32x2 ov = {pack2(t[i][0], t[i][1]), pack2(t[i][2], t[i][3])}; *(u32x2*)(dst + i * 256 + lane * 4) = ov; }
  if (lane == 0) *rstd = rsqrtf(ss * (1.f / 1024.f) + EPS);
}

#define XB_TMO      128
#define XB_XCNT(j)  (256  + 64 * (j))
#define XB_XSUB(j)  (1280 + 64 * (j))
#define XB_XGEN(j)  (2304 + 64 * (j))
#define XB_TOP      3328
#define XB_TOPGEN   3392
#define XCD_BAR_WORDS 3456
#define XB_FLAG 3520
#define XB_ALL_WORDS 3584
#define XB_SPIN_CAP (1u << 18)
#define LAS __attribute__((address_space(3)))
DI unsigned xb_ld(unsigned* p) { return __hip_atomic_load(p, __ATOMIC_RELAXED, __HIP_MEMORY_SCOPE_AGENT); }
DI unsigned xb_add(unsigned* p, unsigned v) { return __hip_atomic_fetch_add(p, v, __ATOMIC_RELAXED, __HIP_MEMORY_SCOPE_AGENT); }
DI unsigned xb_xcc_id() { return (unsigned)__builtin_amdgcn_s_getreg((3 << 11) | 20) & 0xFu; }
#define XB_SPIN(cond, bar) do { unsigned _sp = 0; while (cond) { __builtin_amdgcn_s_sleep(1); \
    if ((++_sp & 255u) == 0u) { if (xb_ld(&(bar)[XB_TMO])) break; if (_sp > XB_SPIN_CAP) { atomicAdd(&(bar)[XB_TMO], 1u); break; } } } } while (0)
struct XcdBarrier { unsigned* bar; unsigned x; volatile LAS unsigned* st; };
DI XcdBarrier xcd_barrier_post(unsigned* bar, volatile LAS unsigned* st) {
  XcdBarrier b; b.bar = bar; b.x = xb_xcc_id(); b.st = st;
  if (threadIdx.x == 0) st[2] = xb_add(&bar[XB_XCNT(b.x)], 1u);
  return b;
}
DI void xcd_barrier_complete(unsigned* bar, unsigned x, unsigned& nloc, unsigned& nx) {
  const unsigned G = gridDim.x * gridDim.y * gridDim.z;
  unsigned sum, cnt, mine, sp = 0u;
  for (;;) {
    sum = 0u; cnt = 0u; mine = 0u;
#pragma unroll
    for (unsigned j = 0; j < 16; ++j) { const unsigned c = xb_ld(&bar[XB_XCNT(j)]); sum += c; cnt += (c > 0u) ? 1u : 0u; mine = (j == x) ? c : mine; }
    if (sum == G) break;
    __builtin_amdgcn_s_sleep(1);
    if ((++sp & 255u) == 0u) { if (xb_ld(&bar[XB_TMO])) break; if (sp > XB_SPIN_CAP) { atomicAdd(&bar[XB_TMO], 1u); break; } }
  }
  nloc = mine > 0u ? mine : 1u; nx = cnt > 0u ? cnt : 1u;
}
DI void xcd_barrier(const XcdBarrier& b) {
  asm volatile("s_waitcnt vmcnt(0)" ::: "memory");
  __syncthreads();
  if (threadIdx.x == 0) {
    unsigned* bar = b.bar;
    __builtin_amdgcn_s_waitcnt(0);
    unsigned nloc = b.st[0], nx = b.st[1];
    if (nloc == 0u) { xcd_barrier_complete(bar, b.x, nloc, nx); b.st[0] = nloc; b.st[1] = nx; }
    const unsigned old = xb_add(&bar[XB_XSUB(b.x)], 1u);
    const unsigned gen = old / nloc;
    if (old + 1u == (gen + 1u) * nloc) {
      __builtin_amdgcn_fence(__ATOMIC_RELEASE, "agent");
      asm volatile("s_waitcnt vmcnt(0)" ::: "memory");
      const unsigned og = xb_add(&bar[XB_TOP], 1u);
      const unsigned tg = og / nx;
      if (og + 1u == (tg + 1u) * nx) xb_add(&bar[XB_TOPGEN], 1u);
      else XB_SPIN(xb_ld(&bar[XB_TOPGEN]) == tg, bar);
      __builtin_amdgcn_fence(__ATOMIC_ACQUIRE, "agent");
      xb_add(&bar[XB_XGEN(b.x)], 1u);
      asm volatile("s_waitcnt vmcnt(0)" ::: "memory");
    } else {
      XB_SPIN(xb_ld(&bar[XB_XGEN(b.x)]) == gen, bar);
      __builtin_amdgcn_fence(__ATOMIC_ACQUIRE, "agent");
      asm volatile("s_waitcnt vmcnt(0)" ::: "memory");
    }
  }
  __syncthreads();
}

template <int PH>
DI void run_phase(const Params& p, char* smem, int vbid) {
  const int bid = blockIdx.x, nb = gridDim.x, tid = threadIdx.x, NT = 512;
  if constexpr (PH == 0) {
    {
      const int lane = tid & 63, w = tid >> 6;
#pragma unroll 1
      for (int u = bid; u < (NTOK + 256) / 16; u += nb) {
        const int row0 = u * 16 + w * 2;
        f32x4 t[2][4];
        const float* src[2]; bf16* dst[2]; float* rs[2];
#pragma unroll
        for (int q = 0; q < 2; ++q) {
          const int row = row0 + q;
          if (row < NTOK) { src[q] = xrow(p, row); dst[q] = p.xb + (size_t)row * 1024; rs[q] = p.rstd_a + row; }
          else { src[q] = p.memp + (size_t)(row - NTOK) * 1024; dst[q] = p.memb + (size_t)(row - NTOK) * 1024; rs[q] = p.rstd_mem + (row - NTOK); }
#pragma unroll
          for (int i = 0; i < 4; ++i) t[q][i] = *(const f32x4*)(src[q] + i * 256 + lane * 4);
        }
#pragma unroll
        for (int q = 0; q < 2; ++q) {
          float ss = 0.f;
#pragma unroll
          for (int i = 0; i < 4; ++i) ss += t[q][i][0] * t[q][i][0] + t[q][i][1] * t[q][i][1] + t[q][i][2] * t[q][i][2] + t[q][i][3] * t[q][i][3];
#pragma unroll
          for (int o = 32; o > 0; o >>= 1) ss += __shfl_xor(ss, o);
#pragma unroll
          for (int i = 0; i < 4; ++i) { u32x2 ov = {pack2(t[q][i][0], t[q][i][1]), pack2(t[q][i][2], t[q][i][3])}; *(u32x2*)(dst[q] + i * 256 + lane * 4) = ov; }
          if (lane == 0) *rs[q] = rsqrtf(ss * (1.f / 1024.f) + EPS);
        }
      }
    }
#pragma unroll 1
    for (int u = bid; u < 978; u += nb) {
      int t = u * 2 + (tid >> 8);
      const float* src; const float* gain = nullptr; bf16* dst; int K = 1024, N = 1024;
      if (t < 512) { src = p.w_in_a; N = 2048; gain = p.norm_a; dst = p.Wt_in_a; }
      else if ((t -= 512) < 256) { src = p.w_out_a; dst = p.Wt_out_a; }
      else if ((t -= 256) < 128) { src = p.w_kv; N = 512; gain = p.kv_norm; dst = p.Wt_kvb; }
      else if ((t -= 128) < 512) { src = p.w_in_b; N = 2048; gain = p.norm_b; dst = p.Wt_kvb + 512 * 1024; }
      else if ((t -= 512) < 256) { src = p.w_out_b; dst = p.Wt_out_b; }
      else if ((t -= 256) < 256) { const int l = t >> 7; t &= 127; src = p.w_mem_kv + (size_t)l * 1024 * 512; N = 512; gain = p.mem_norm + l * 1024; dst = p.Wt_mem + (size_t)l * 512 * 1024; }
      else { t -= 256; const int g = t / 9; t %= 9; src = p.pool_mix_w + (size_t)g * 192 * 192; K = 192; N = 192; dst = p.Wt_pool + (size_t)g * 192 * 768 + g * 192; }
      if (K == 192) {
        const int ltid = tid & 255;
        float* T = (float*)(smem + (tid >> 8) * 16640);
        const int k0 = (t / 3) << 6, n0 = (t % 3) << 6, c4 = ltid & 15, ri = ltid >> 4;
#pragma unroll
        for (int i = 0; i < 4; ++i) {
          const int k = ri + 16 * i;
          f32x4 x = *(const f32x4*)(src + (size_t)(k0 + k) * 192 + n0 + c4 * 4);
          T[k * 65 + c4 * 4] = x[0]; T[k * 65 + c4 * 4 + 1] = x[1]; T[k * 65 + c4 * 4 + 2] = x[2]; T[k * 65 + c4 * 4 + 3] = x[3];
        }
      }
      if (K != 192) transpose_tile(src, K, N, gain, dst, t, smem, true);
      else {
        __syncthreads();
        const int ltid = tid & 255, k8 = ltid & 7, nn = ltid >> 3;
        const float* T = (const float*)(smem + (tid >> 8) * 16640);
        const int k0 = (t / 3) << 6, n0 = (t % 3) << 6;
#pragma unroll
        for (int i = 0; i < 2; ++i) {
          const int n = nn + 32 * i;
          const float* tp = T + (k8 * 8) * 65 + n;
          u32x4 o = {pack2(tp[0], tp[65]), pack2(tp[130], tp[195]), pack2(tp[260], tp[325]), pack2(tp[390], tp[455])};
          *(u32x4*)(dst + (size_t)(n0 + n) * 768 + k0 + k8 * 8) = o;
        }
        __syncthreads();
      }
    }
    for (int i = bid * NT + tid; i < 768 * 96; i += nb * NT) {
      const int n = i / 96, k8 = i % 96;
      if (n / 192 != k8 / 24) { u32x4 zz = {0u, 0u, 0u, 0u}; *(u32x4*)(p.Wt_pool + (size_t)n * 768 + k8 * 8) = zz; }
    }
    for (int i = bid * NT + tid; i < NTOK; i += nb * NT) p.ssq1[i] = 0.f;
    for (int i = bid * NT + tid; i < 128 * 7 * 192; i += nb * NT) {
      const int b = i / (7 * 192), rem = i % (7 * 192);
      *(f32x4*)(p.out + O_POOLS + (size_t)b * 15 * 768 + rem * 4) = *(const f32x4*)(p.state_pool + (size_t)b * 15 * 768 + 8 * 768 + rem * 4);
    }
  } else if constexpr (PH == 1) {
    gemm_phase(p.xb, 1024, p.Wt_in_a, 1024, 16, 68, 8, smem, EpiInA{p}, vbid);
#pragma unroll 1
    for (int v = nb - 1 - ((nb & 255) == 0 ? ((vbid & 31) * (nb >> 5) + (vbid >> 5)) : vbid); v < 16; v += nb) gemm_tile<128, 128>(p.memb, 1024, p.Wt_mem, 1024, 16, (v >> 3) * 128, (v & 7) * 128, smem, EpiMemKV{p});
  } else if constexpr (PH == 2) {
#pragma unroll 1
    for (int u = bid; u < 256; u += nb) mem_attn_prompt(p, 0, u, smem);
    {
      bf16* dbuf = p.dbuf;
      const int lane = tid & 63, gw = bid * 8 + (tid >> 6), nw = nb * 8;
#pragma unroll 1
      for (int it = gw; it < (NTOK / 8) * 4; it += nw) {
        const int tg = it >> 2, g = it & 3;
        const int tok = tg * 8 + (lane >> 3), c0 = g * 192 + (lane & 7) * 8;
        if (g == 0) { pool_d_item<2>(p, tok, c0, dbuf); pool_d_item<2>(p, tok, c0 + 64, dbuf); pool_d_item<2>(p, tok, c0 + 128, dbuf); }
        else if (g == 1) { pool_d_item<4>(p, tok, c0, dbuf); pool_d_item<4>(p, tok, c0 + 64, dbuf); pool_d_item<4>(p, tok, c0 + 128, dbuf); }
        else if (g == 2) { pool_d_item<8>(p, tok, c0, dbuf); pool_d_item<8>(p, tok, c0 + 64, dbuf); pool_d_item<8>(p, tok, c0 + 128, dbuf); }
        else { pool_d_item<16>(p, tok, c0, dbuf); pool_d_item<16>(p, tok, c0 + 64, dbuf); pool_d_item<16>(p, tok, c0 + 128, dbuf); }
      }
    }
  } else if constexpr (PH == 3) {
    const int vb = vbid, NG = 68 * 3;
    if (nb >= NG + 32) {
      if (vb < NG) {
        const int mt = vb / 3, nt = vb % 3;
        gemm_tile<256, 256>(p.dbuf + nt * 192, 768, p.Wt_pool + nt * 192, 768, 6, mt * 256, nt * 256, smem, EpiPool{p});
      } else {
        decode_mem_loop(p, 0, vb - NG, nb - NG, smem);
      }
    } else {
#pragma unroll 1
      for (int u = vb; u < NG; u += nb) {
        const int mt = u / 3, nt = u % 3;
        gemm_tile<256, 256>(p.dbuf + nt * 192, 768, p.Wt_pool + nt * 192, 768, 6, mt * 256, nt * 256, smem, EpiPool{p});
      }
#pragma unroll 1
      for (int u = bid; u < 256; u += nb) decode_unit<false>(p, 0, u, smem);
    }
  } else if constexpr (PH == 4) {
    if (nb == 256) {
      const int u = vbid;
      gemm_tile<256, 256>(p.act, 1024, p.Wt_out_a, 1024, 16, (u >> 2) * 256, (u & 3) * 256, smem, EpiOutA{p});
    } else {
      gemm_phase(p.act, 1024, p.Wt_out_a, 1024, 16, 68, 4, smem, EpiOutA{p}, vbid);
    }
  } else if constexpr (PH == 5) {
    if (nb == 256) {
      if (vbid >= 192) {
        const int sidx = vbid - 192, u4 = 256 + (sidx >> 2), q = sidx & 3;
        gemm_tile<128, 128>(p.act, 1024, p.Wt_out_a, 1024, 16, (u4 >> 2) * 256 + (q >> 1) * 128, (u4 & 3) * 256 + (q & 1) * 128, smem, EpiOutA{p});
        asm volatile("s_waitcnt vmcnt(0)" ::: "memory");
        __syncthreads();
        if (tid == 0) {
          __builtin_amdgcn_fence(__ATOMIC_RELEASE, "agent");
          asm volatile("s_waitcnt vmcnt(0)" ::: "memory");
          (void)xb_add(&p.bar[XB_FLAG], 1u);
        }
      }
#pragma unroll 1
      for (int u = vbid; u < 680; u += nb) {
        int mt = u / 10;
        const int nt = u % 10;
        if (u >= 640) {
          if (tid == 0) {
            XB_SPIN(xb_ld(&p.bar[XB_FLAG]) < 64u, p.bar);
            __builtin_amdgcn_fence(__ATOMIC_ACQUIRE, "agent");
            asm volatile("s_waitcnt vmcnt(0)" ::: "memory");
          }
          __syncthreads();
        }
        gemm_tile<256, 256>(p.xb, 1024, p.Wt_kvb, 1024, 16, mt * 256, nt * 256, smem, EpiKVB{p});
      }
    } else {
      gemm_phase(p.xb, 1024, p.Wt_kvb, 1024, 16, 68, 10, smem, EpiKVB{p}, vbid);
    }
  } else if constexpr (PH == 6) {
#pragma unroll 1
    for (int u = bid; u < 256; u += nb) swa_prompt(p, u, smem);
#pragma unroll 1
    for (int u = bid; u < 256; u += nb) mem_attn_prompt(p, 1, u, smem);
#pragma unroll 1
    for (int u = bid; u < 256; u += nb) decode_unit<true>(p, 1, u, smem);
#pragma unroll 1
    for (int u = bid; u < 256; u += nb) decode_unit<false>(p, 1, u, smem);
  } else if constexpr (PH == 7) {
    gemm_phase(p.act, 1024, p.Wt_out_b, 1024, 16, 68, 4, smem, EpiOutB{p}, vbid);
  }
}

#if MULTI_LAUNCH
template <int PH>
__global__ void __launch_bounds__(512) phase_kernel(Params p) {
  __shared__ __attribute__((aligned(1024))) char smem[135168];
  run_phase<PH>(p, smem, blockIdx.x);
}
#else
__global__ void __launch_bounds__(512) yoco_megakernel(Params p) {
  __shared__ __attribute__((aligned(1024))) char smem[135168];
  __shared__ uint4 xb_words;
  if (threadIdx.x == 0) xb_words = make_uint4(0u, 0u, 0u, 0u);
  __syncthreads();
  XcdBarrier xb = xcd_barrier_post(p.bar, (volatile LAS unsigned*)&xb_words);
  run_phase<0>(p, smem, blockIdx.x); xcd_barrier(xb);
  if (threadIdx.x == 0) {
    const unsigned per = gridDim.x >> 3;
    bool even = (gridDim.x & 7u) == 0u;
    for (unsigned j = 0; j < 16; ++j) { const unsigned c = xb_ld(&p.bar[XB_XCNT(j)]); even = even && (j < 8 ? c == per : c == 0u); }
    const unsigned rank = ((volatile LAS unsigned*)&xb_words)[2];
    ((volatile LAS unsigned*)&xb_words)[3] = even ? xb.x * per + rank : blockIdx.x;
  }
  __syncthreads();
  const int vbid = (int)((volatile LAS unsigned*)&xb_words)[3];
  run_phase<1>(p, smem, vbid); xcd_barrier(xb);
  run_phase<2>(p, smem, vbid); xcd_barrier(xb);
  run_phase<3>(p, smem, vbid); xcd_barrier(xb);
  run_phase<4>(p, smem, vbid); xcd_barrier(xb);
  run_phase<5>(p, smem, vbid); xcd_barrier(xb);
  run_phase<6>(p, smem, vbid); xcd_barrier(xb);
  run_phase<7>(p, smem, vbid);
}
#endif

extern "C" void kernel_launch(void* const* d_in, const int* in_sizes, int n_in, void* d_out, int out_size, void* d_ws, size_t ws_size, hipStream_t stream) {
  Params p{};
  const float* const* in = (const float* const*)d_in;
  p.xp = in[0]; p.xs = in[1]; p.state_pool = in[2]; p.cswk = in[3]; p.cswv = in[4]; p.cmk = in[5]; p.cmv = in[6]; p.memp = in[7];
  p.norm_a = in[8]; p.w_in_a = in[9]; p.pool_mix_w = in[10]; p.pool_scale = in[11]; p.w_out_a = in[12]; p.kv_norm = in[13]; p.w_kv = in[14];
  p.k_norm = in[15]; p.norm_b = in[16]; p.w_in_b = in[17]; p.q_norm = in[18]; p.sinks = in[19]; p.w_out_b = in[20]; p.mem_norm = in[21];
  p.w_mem_kv = in[22]; p.mem_q_norm = in[23]; p.mem_k_norm = in[24];
  p.out = (float*)d_out;
  char* ws = (char*)d_ws;
  size_t off = 0;
  auto take = [&](size_t bytes) { char* r = ws + off; off += (bytes + 255) & ~(size_t)255; return r; };
  p.Wt_in_a = (bf16*)take((size_t)2048 * 1024 * 2);
  p.Wt_out_a = (bf16*)take((size_t)1024 * 1024 * 2);
  p.Wt_kvb = (bf16*)take((size_t)2560 * 1024 * 2);
  p.Wt_out_b = (bf16*)take((size_t)1024 * 1024 * 2);
  p.Wt_mem = (bf16*)take((size_t)1024 * 1024 * 2);
  p.Wt_pool = (bf16*)take((size_t)768 * 768 * 2);
  p.memb = (bf16*)take((size_t)256 * 1024 * 2);
  p.mkb = (bf16*)take((size_t)4 * 256 * 256 * 2);
  p.rstd_a = (float*)take((size_t)NTOK * 4);
  p.rstd_mem = (float*)take(256 * 4);
  p.ssq1 = (float*)take((size_t)NTOK * 4);
  p.bar = (unsigned*)take((size_t)XB_ALL_WORDS * 4);
  p.xb = (bf16*)take((size_t)NTOK * 1024 * 2);
  p.act = (bf16*)take((size_t)NTOK * 1024 * 2);
  p.dbuf = (bf16*)take((size_t)NTOK * 768 * 2);
  p.z = (bf16*)take((size_t)NTOK * 2560 * 2);
  for (int i = 0; i < 8; ++i) p.rope_inv[i] = powf(500000.0f, -(float)i / 8.0f);
#if MULTI_LAUNCH
  const int grid = 256;
  phase_kernel<0><<<grid, 512, 0, stream>>>(p);
  phase_kernel<1><<<grid, 512, 0, stream>>>(p);
  phase_kernel<2><<<grid, 512, 0, stream>>>(p);
  phase_kernel<3><<<grid, 512, 0, stream>>>(p);
  phase_kernel<4><<<grid, 512, 0, stream>>>(p);
  phase_kernel<5><<<grid, 512, 0, stream>>>(p);
  phase_kernel<6><<<grid, 512, 0, stream>>>(p);
  phase_kernel<7><<<grid, 512, 0, stream>>>(p);
#else
  static int grid_blocks = 0;
  if (!grid_blocks) {
    int dev = 0, cus = 0, per_cu = 0;
    hipGetDevice(&dev);
    hipDeviceGetAttribute(&cus, hipDeviceAttributeMultiprocessorCount, dev);
    (void)hipOccupancyMaxActiveBlocksPerMultiprocessor(&per_cu, yoco_megakernel, 512, 0);
    if (per_cu > 1) per_cu = 1;
    grid_blocks = cus * per_cu;
  }
  (void)hipMemsetAsync(p.bar, 0, (size_t)XB_ALL_WORDS * 4, stream);
  void* args[] = {&p};
  hipError_t e = hipLaunchCooperativeKernel((void*)yoco_megakernel, dim3(grid_blocks), dim3(512), args, 0, stream);
  if (e != hipSuccess) fprintf(stderr, "cooperative launch failed: %s (grid %d)\n", hipGetErrorString(e), grid_blocks);
#endif
}
```
